# Optimizing an MI355X kernel written in HIP

```python
import math
import jax, jax.numpy as jnp
from jax import lax
import numpy as np

D_MODEL = 1024
BATCH = 8
SEQ = 4096
DEPTH = 4

HEAD_DIM = 64
SWA_Q_HEADS = 8
SWA_KV_HEADS = 2
SWA_GROUP = SWA_Q_HEADS // SWA_KV_HEADS
WINDOW = 128
FOX_HEADS = 4
MLA_HEADS = 4
MLA_Q_RANK = 256
MLA_KV_RANK = 128
MLA_NOPE_DIM = 64
MLA_ROPE_DIM = 32
MLA_V_DIM = 64
ROPE_THETA = 10000.0
REL_BUCKETS = 32
REL_MAX_DIST = 128
D_FF = 2816
CONV_WIDTH = 3
Q_BLOCK = 128
EPS = 1e-6
NEG_INF = -1e30

SWA_WIDTH = SWA_Q_HEADS * HEAD_DIM
FOX_WIDTH = FOX_HEADS * HEAD_DIM
MLA_WIDTH = MLA_HEADS * MLA_V_DIM
MIX_WIDTH = SWA_WIDTH + FOX_WIDTH + MLA_WIDTH
SWA_COLS = (SWA_Q_HEADS + 2 * SWA_KV_HEADS) * HEAD_DIM
FOX_COLS = 3 * FOX_HEADS * HEAD_DIM + FOX_HEADS
MLA_COLS = MLA_Q_RANK + MLA_KV_RANK + MLA_ROPE_DIM
IN_COLS = SWA_COLS + FOX_COLS + MLA_COLS
MLA_QK_DIM = MLA_NOPE_DIM + MLA_ROPE_DIM

kernel_name = "hymba_swa_fox_mla_convffn_trunk"


def rmsnorm(x, g):
    xf = x.astype(jnp.float32)
    y = xf * lax.rsqrt(jnp.mean(xf * xf, axis=-1, keepdims=True) + EPS) * g.astype(jnp.float32)
    return y.astype(x.dtype)


def t5_causal_bucket(dist):
    max_exact = REL_BUCKETS // 2
    d = jnp.maximum(dist, 0)
    log_ratio = jnp.log(jnp.maximum(d, 1).astype(jnp.float32) / max_exact) / math.log(REL_MAX_DIST / max_exact)
    large = max_exact + (log_ratio * (REL_BUCKETS - max_exact)).astype(jnp.int32)
    large = jnp.minimum(large, REL_BUCKETS - 1)
    return jnp.where(d < max_exact, d, large)


def apply_rope(t, cos, sin):
    t1, t2 = jnp.split(t, 2, axis=-1)
    return jnp.concatenate([t1 * cos - t2 * sin, t1 * sin + t2 * cos], axis=-1)


def swa_sink_attention(q, k, v, sinks, rel_bias):
    B, S = q.shape[0], q.shape[1]
    nb = S // WINDOW
    qb = q.reshape(B, nb, WINDOW, SWA_KV_HEADS, SWA_GROUP, HEAD_DIM)

    def band(t):
        tb = t.reshape(B, nb, WINDOW, SWA_KV_HEADS, HEAD_DIM)
        prev = jnp.pad(tb, ((0, 0), (1, 0), (0, 0), (0, 0), (0, 0)))[:, :-1]
        return jnp.concatenate([prev, tb], axis=2)

    kb, vb = band(k), band(v)
    qi = jnp.arange(WINDOW, dtype=jnp.int32)[:, None] + WINDOW
    kj = jnp.arange(2 * WINDOW, dtype=jnp.int32)[None, :]
    dist = qi - kj
    in_band = (dist >= 0) & (dist < WINDOW)
    valid_key = (jnp.arange(nb)[:, None, None] > 0) | (kj >= WINDOW)[None]
    mask = in_band[None] & valid_key
    bias = rel_bias.astype(jnp.float32)[t5_causal_bucket(dist)]
    bias = bias.transpose(2, 0, 1).reshape(SWA_KV_HEADS, SWA_GROUP, WINDOW, 2 * WINDOW)
    s = jnp.einsum('bnqhgd,bnkhd->bnhgqk', qb, kb, preferred_element_type=jnp.float32)
    s = s * (HEAD_DIM ** -0.5) + bias
    s = jnp.where(mask[None, :, None, None], s, NEG_INF)
    sink = sinks.astype(jnp.float32).reshape(1, 1, SWA_KV_HEADS, SWA_GROUP, 1, 1)
    sink = jnp.broadcast_to(sink, s.shape[:-1] + (1,))
    p = jax.nn.softmax(jnp.concatenate([s, sink], axis=-1), axis=-1)[..., :-1]
    o = jnp.einsum('bnhgqk,bnkhd->bnqhgd', p.astype(v.dtype), vb)
    return o.reshape(B, S, SWA_Q_HEADS * HEAD_DIM)


def blocked_causal_attention(q, k, v, scale, log_forget_cum=None):
    B, S, H = q.shape[0], q.shape[1], q.shape[2]
    nb = S // Q_BLOCK
    q_blocks = q.reshape(B, nb, Q_BLOCK, H, q.shape[-1]).swapaxes(0, 1)
    k_pos = jnp.arange(S, dtype=jnp.int32)
    if log_forget_cum is None:
        f_blocks, f_keys = None, None
    else:
        f_t = log_forget_cum.transpose(0, 2, 1)
        f_blocks = f_t.reshape(B, H, nb, Q_BLOCK).transpose(2, 0, 1, 3)
        f_keys = f_t

    def one_block(args):
        qb, fb, i = args
        s = jnp.einsum('bqhd,bkhd->bhqk', qb, k, preferred_element_type=jnp.float32) * scale
        if fb is not None:
            s = s + (fb[..., :, None] - f_keys[..., None, :])
        q_pos = i * Q_BLOCK + jnp.arange(Q_BLOCK, dtype=jnp.int32)
        s = jnp.where(k_pos[None, :] <= q_pos[:, None], s, NEG_INF)
        p = jax.nn.softmax(s, axis=-1)
        return jnp.einsum('bhqk,bkhd->bqhd', p.astype(v.dtype), v)

    out = lax.map(one_block, (q_blocks, f_blocks, jnp.arange(nb, dtype=jnp.int32)))
    return out.swapaxes(0, 1).reshape(B, S, H * v.shape[-1])


def causal_depthwise_conv(u, w, b):
    S = u.shape[1]
    up = jnp.pad(u, ((0, 0), (CONV_WIDTH - 1, 0), (0, 0)))
    y = b.astype(u.dtype)
    for tap in range(CONV_WIDTH):
        y = y + w[tap].astype(u.dtype) * up[:, tap:tap + S]
    return y


def setup_inputs(seed: int = 0) -> dict:
    key = jax.random.key(seed)
    ks = jax.random.split(key, 20)
    L, D = DEPTH, D_MODEL
    f32 = jnp.float32

    def nrm(k, shape, scale):
        return jax.random.normal(k, shape, f32) * scale

    def gain(k, shape):
        return 1.0 + 0.05 * jax.random.normal(k, shape, f32)

    return {
        "x": jax.random.normal(ks[0], (BATCH, SEQ, D), f32),
        "attn_pre_norm": gain(ks[1], (L, D)),
        "w_in": nrm(ks[2], (L, D, IN_COLS), D ** -0.5),
        "forget_bias": 2.0 + 0.5 * jax.random.normal(ks[3], (L, FOX_HEADS), f32),
        "swa_sinks": nrm(ks[4], (L, SWA_Q_HEADS), 0.5),
        "rel_bias": nrm(ks[5], (REL_BUCKETS, SWA_Q_HEADS), 0.5),
        "q_latent_norm": gain(ks[6], (L, MLA_Q_RANK)),
        "w_uq": nrm(ks[7], (L, MLA_Q_RANK, MLA_HEADS * MLA_QK_DIM), MLA_Q_RANK ** -0.5),
        "kv_latent_norm": gain(ks[8], (L, MLA_KV_RANK)),
        "w_ukv": nrm(ks[9], (L, MLA_KV_RANK, MLA_HEADS * (MLA_NOPE_DIM + MLA_V_DIM)), MLA_KV_RANK ** -0.5),
        "group_norm": gain(ks[10], (L, MIX_WIDTH)),
        "w_out": nrm(ks[11], (L, MIX_WIDTH, D), MIX_WIDTH ** -0.5),
        "attn_post_norm": gain(ks[12], (L, D)),
        "ffn_pre_norm": gain(ks[13], (L, D)),
        "w_up": nrm(ks[14], (L, D, 2 * D_FF), D ** -0.5),
        "conv_w": nrm(ks[15], (L, CONV_WIDTH, 2 * D_FF), CONV_WIDTH ** -0.5),
        "conv_b": nrm(ks[16], (L, 2 * D_FF), 0.02),
        "w_down": nrm(ks[17], (L, D_FF, D), D_FF ** -0.5),
        "ffn_post_norm": gain(ks[18], (L, D)),
    }


def reference(x, attn_pre_norm, w_in, forget_bias, swa_sinks, rel_bias, q_latent_norm, w_uq,
              kv_latent_norm, w_ukv, group_norm, w_out, attn_post_norm, ffn_pre_norm, w_up,
              conv_w, conv_b, w_down, ffn_post_norm):
    B, S, _ = x.shape
    pos = jnp.arange(S, dtype=jnp.float32)
    inv_freq = ROPE_THETA ** (-(jnp.arange(MLA_ROPE_DIM // 2, dtype=jnp.float32) * 2.0 / MLA_ROPE_DIM))
    ang = pos[:, None] * inv_freq[None, :]
    cos = jnp.cos(ang)[:, None, :].astype(x.dtype)
    sin = jnp.sin(ang)[:, None, :].astype(x.dtype)

    for l in range(DEPTH):
        h = rmsnorm(x, attn_pre_norm[l])
        proj = h @ w_in[l]
        a_cols, f_cols, m_cols = jnp.split(proj, [SWA_COLS, SWA_COLS + FOX_COLS], axis=-1)

        qa, ka, va = jnp.split(a_cols, [SWA_WIDTH, SWA_WIDTH + SWA_KV_HEADS * HEAD_DIM], axis=-1)
        out_a = swa_sink_attention(qa.reshape(B, S, SWA_Q_HEADS, HEAD_DIM),
                                   ka.reshape(B, S, SWA_KV_HEADS, HEAD_DIM),
                                   va.reshape(B, S, SWA_KV_HEADS, HEAD_DIM),
                                   swa_sinks[l], rel_bias)

        qf, kf, vf, f_logit = jnp.split(f_cols, [FOX_WIDTH, 2 * FOX_WIDTH, 3 * FOX_WIDTH], axis=-1)
        log_f = jax.nn.log_sigmoid(f_logit.astype(jnp.float32) + forget_bias[l].astype(jnp.float32))
        F = jnp.cumsum(log_f, axis=1)
        out_b = blocked_causal_attention(qf.reshape(B, S, FOX_HEADS, HEAD_DIM),
                                         kf.reshape(B, S, FOX_HEADS, HEAD_DIM),
                                         vf.reshape(B, S, FOX_HEADS, HEAD_DIM),
                                         HEAD_DIM ** -0.5, log_forget_cum=F)

        c_q, c_kv, k_rope = jnp.split(m_cols, [MLA_Q_RANK, MLA_Q_RANK + MLA_KV_RANK], axis=-1)
        qm = (rmsnorm(c_q, q_latent_norm[l]) @ w_uq[l]).reshape(B, S, MLA_HEADS, MLA_QK_DIM)
        q_nope, q_rope = jnp.split(qm, [MLA_NOPE_DIM], axis=-1)
        kv = (rmsnorm(c_kv, kv_latent_norm[l]) @ w_ukv[l]).reshape(B, S, MLA_HEADS, MLA_NOPE_DIM + MLA_V_DIM)
        k_nope, vm = jnp.split(kv, [MLA_NOPE_DIM], axis=-1)
        q_rope = apply_rope(q_rope, cos, sin)
        k_rope = jnp.broadcast_to(apply_rope(k_rope[:, :, None, :], cos, sin), (B, S, MLA_HEADS, MLA_ROPE_DIM))
        out_c = blocked_causal_attention(jnp.concatenate([q_nope, q_rope], axis=-1),
                                         jnp.concatenate([k_nope, k_rope], axis=-1),
                                         vm, MLA_QK_DIM ** -0.5)

        g_a, g_b, g_c = jnp.split(group_norm[l], [SWA_WIDTH, SWA_WIDTH + FOX_WIDTH])
        mixed = jnp.concatenate([rmsnorm(out_a, g_a), rmsnorm(out_b, g_b), rmsnorm(out_c, g_c)], axis=-1)
        x = x + rmsnorm(mixed @ w_out[l], attn_post_norm[l])

        h = rmsnorm(x, ffn_pre_norm[l])
        u = causal_depthwise_conv(h @ w_up[l], conv_w[l], conv_b[l])
        gate, up = jnp.split(u, 2, axis=-1)
        y = (jax.nn.gelu(gate, approximate=True) * up) @ w_down[l]
        x = x + rmsnorm(y, ffn_post_norm[l])
    return x
```

```cpp
#include <hip/hip_runtime.h>
#include <hip/hip_cooperative_groups.h>
#include <cstdio>
#include <cstdint>
namespace cg = cooperative_groups;
#define MK_COOP 1
namespace pg8 {
#define PG8_LAS __attribute__((address_space(3)))
typedef unsigned short bf16_t;
typedef short bf16x8 __attribute__((ext_vector_type(8)));
typedef float f32x4 __attribute__((ext_vector_type(4)));
typedef unsigned u32x4 __attribute__((ext_vector_type(4)));
constexpr int BM = 256, BK = 64, HALF = 128, HTB = HALF * BK * 2  , STAGE_BYTES = 8 * HTB, NXCD = 8, WGM = 8;

__host__ __device__ __forceinline__ int lds_byte(int r, int c) { const int st = (r >> 4) * 2 + (c >> 5), rr = r & 15, cc = c & 31, ob = rr * 64 + cc * 2; return st * 1024 + (ob ^ (((ob >> 9) & 1) << 5)); }
__host__ __device__ __forceinline__ void stage_rc(int b, int& R, int& C) { const int st = b / 1024, sb = b % 1024, swz = sb ^ (((sb >> 9) & 1) << 5); R = (st >> 1) * 16 + swz / 64; C = (st & 1) * 32 + (swz % 64) / 2; }
__host__ __device__ __forceinline__ int perm32(int rho) { const int n = rho >> 4, i = rho & 15; return 8 * (i >> 2) + 4 * n + (i & 3); }

struct Unit { int pm, pn; };
struct Gemm { const bf16_t* A; const bf16_t* Bt; int M, N, K; const char* Asplit = nullptr;
    __device__ __forceinline__ const char* apanel(int pm, size_t tstep) const {
        if (!Asplit) return (const char*)A + (size_t)pm * tstep;
        const int gb = pm >> 4, j = pm & 15;
        return j < 11 ? (const char*)A + ((size_t)gb << 24) + (size_t)j * tstep : Asplit + ((size_t)gb << 23) + (size_t)(j - 11) * tstep;
    } };

struct StaticOrder {
    int nM, nN, nwg, G, c;
    __host__ __device__ void init(int M, int N, int G_, int c_) { nM = M / BM; nN = N / BM; nwg = nM * nN; G = G_; c = c_; }
    __host__ __device__ bool next(int i, Unit& u) const {
        const long L = (long)i * G + c; if (L >= nwg) return false;
        int wgid = (int)L; { const int q = nwg / NXCD, r = nwg % NXCD, xcd = wgid % NXCD, off = wgid / NXCD; wgid = (xcd < r ? xcd * (q + 1) : r * (q + 1) + (xcd - r) * q) + off; }
        const int nig = WGM * nN, gid = wgid / nig, fm = gid * WGM, gsz = (nM - fm) < WGM ? (nM - fm) : WGM;
        u.pm = fm + ((wgid % nig) % gsz); u.pn = (wgid % nig) / gsz; return true;
    }
    __device__ __forceinline__ void a_ready(const Unit&) const {}
    __device__ __forceinline__ void done(const Unit&) const {}
};

__device__ __forceinline__ unsigned cvt_pk_bf16(float lo, float hi) { unsigned r; asm volatile("v_cvt_pk_bf16_f32 %0, %1, %2" : "=v"(r) : "v"(lo), "v"(hi)); return r; }
typedef float f32x2 __attribute__((ext_vector_type(2)));
__device__ __forceinline__ f32x2 gelu_pk(f32x2 v) {
    const f32x2 av = __builtin_elementwise_abs(v), d = av * 0.2316418882f + 1.0f;
    f32x2 t; t.x = __builtin_amdgcn_rcpf(d.x); t.y = __builtin_amdgcn_rcpf(d.y);
    f32x2 q = t * 0.5307027145f + (-0.7265760135f); q = q * t + 0.7107068705f; q = q * t + (-0.142248368f); q = q * t + 0.127414796f; q = q * t;
    const f32x2 s = (v * v) * (-0.72134752044f);
    f32x2 e; e.x = __builtin_amdgcn_exp2f(s.x); e.y = __builtin_amdgcn_exp2f(s.y);
    const f32x2 m = v * (q * e), r = v - m;
    f32x2 o; o.x = v.x < 0.f ? m.x : r.x; o.y = v.y < 0.f ? m.y : r.y; return o;
}

template <int ACT  > struct EpiBf16 {
    static constexpr bool PERM = true, AFTER_DRAIN = false, KSEG = false; static_assert(ACT == 0 || ACT == 1, "EpiBf16: ACT is 0 (none) or 1 (gelu_pk)");
    bf16_t* O; int ldc; const float* bias; int split_cols; size_t split_stride; float scale0;
    __device__ __forceinline__ void operator()(const f32x4 (&acc)[2][2][4][2], const Unit& u, int wr, int wc, int fr, int fq) const {
        const int row0 = u.pm * BM + wr * 64 + fr; int colt = u.pn * BM; bf16_t* base = O;
        float sc = 1.f; if (split_cols) { const int t = colt / split_cols; base += (size_t)t * split_stride; colt -= t * split_cols; if (t == 0) sc = scale0; }
        const int col0 = colt + wc * 32 + 8 * fq, bcol0 = u.pn * BM + wc * 32 + 8 * fq;
        f32x4 bv[2][2];
#pragma unroll
        for (int bj = 0; bj < 2; ++bj)
#pragma unroll
            for (int n = 0; n < 2; ++n) bv[bj][n] = bias ? *(const f32x4*)(bias + bcol0 + bj * HALF + 4 * n) : (f32x4){0.f, 0.f, 0.f, 0.f};
#pragma unroll
        for (int ai = 0; ai < 2; ++ai)
#pragma unroll
            for (int m = 0; m < 4; ++m) { bf16_t* rowp = base + (size_t)(row0 + ai * HALF + m * 16) * ldc + col0;
#pragma unroll
                for (int bj = 0; bj < 2; ++bj) { f32x4 v0 = acc[ai][bj][m][0] + bv[bj][0], v1 = acc[ai][bj][m][1] + bv[bj][1];
                    if (ACT == 1) { f32x2 a = gelu_pk((f32x2){v0[0], v0[1]}), b = gelu_pk((f32x2){v0[2], v0[3]}), c = gelu_pk((f32x2){v1[0], v1[1]}), d = gelu_pk((f32x2){v1[2], v1[3]});
                        v0 = (f32x4){a.x, a.y, b.x, b.y}; v1 = (f32x4){c.x, c.y, d.x, d.y}; }
                    v0 = v0 * sc; v1 = v1 * sc; u32x4 w; w.x = cvt_pk_bf16(v0[0], v0[1]); w.y = cvt_pk_bf16(v0[2], v0[3]); w.z = cvt_pk_bf16(v1[0], v1[1]); w.w = cvt_pk_bf16(v1[2], v1[3]);
                    *(u32x4*)(rowp + bj * HALF) = w; } }
    }
};
template <class Epi, class Sched, bool ALIGN_EPI = false, bool SP2 = false>
__device__ __forceinline__ void gemm_phase(PG8_LAS unsigned char* lds, const Gemm g, const Sched& S, const Epi& E, int tid_in) {
    int tid_ = tid_in; asm volatile("" : "+v"(tid_));
    const int tid = tid_, wid = __builtin_amdgcn_readfirstlane(tid >> 6), lane = tid & 63, wr = wid >> 2, wc = wid & 3, fr = lane & 15, fq = lane >> 4;
    const int K = g.K, nt = K / BK;
    unsigned voffA[2], voffB[2];
#pragma unroll
    for (int i = 0; i < 2; ++i) { int R, C; stage_rc(tid * 16 + i * 8192, R, C); const int Rb = Epi::PERM ? ((R & ~31) + perm32(R & 31)) : R;
        voffA[i] = (unsigned)(R * K + C) * 2u; voffB[i] = (unsigned)(Rb * K + C) * 2u; }
    const size_t kstep = (size_t)(BK * 2);
    const size_t hstep = (size_t)HALF * K * 2;
    const size_t tstep = 2 * hstep;
    const unsigned ldsw = (unsigned)wid * 1024u;
    const int aoff = lds_byte(wr * 64 + fr, fq * 8), boff = lds_byte(wc * 32 + fr, fq * 8);
#define PG8_SA(b, h) (((b) * 2 + (h)) * HTB)
#define PG8_SB(b, h) ((4 + (b) * 2 + (h)) * HTB)
#define PG8_STAGE(bufoff, gbase, voff) do { _Pragma("unroll") for (int _i = 0; _i < 2; ++_i) \
        __builtin_amdgcn_global_load_lds((const unsigned*)((const char*)(gbase) + (voff)[_i]), (PG8_LAS unsigned*)(lds + (bufoff) + ldsw + _i * 8192), 16, 0, 0); } while (0)
#define PG8_LDA(dst, b, h) do { _Pragma("unroll") for (int m = 0; m < 4; ++m) _Pragma("unroll") for (int k = 0; k < 2; ++k) dst[m][k] = *(const PG8_LAS bf16x8*)(lds + PG8_SA(b, h) + aoff + m * 2048 + k * 1024); } while (0)
#define PG8_LDB(dst, b, h) do { _Pragma("unroll") for (int n = 0; n < 2; ++n) _Pragma("unroll") for (int k = 0; k < 2; ++k) dst[n][k] = *(const PG8_LAS bf16x8*)(lds + PG8_SB(b, h) + boff + n * 2048 + k * 1024); } while (0)
#define PG8_MMA(ai, bj, At, Bt) do { __builtin_amdgcn_s_setprio(1); _Pragma("unroll") for (int m = 0; m < 4; ++m) _Pragma("unroll") for (int n = 0; n < 2; ++n) _Pragma("unroll") for (int k = 0; k < 2; ++k) \
        acc[ai][bj][m][n] = __builtin_amdgcn_mfma_f32_16x16x32_bf16(Bt[n][k], At[m][k], acc[ai][bj][m][n], 0, 0, 0); __builtin_amdgcn_s_setprio(0); } while (0)
#define PG8_WAIT_V(n) asm volatile("s_waitcnt vmcnt(" #n ")" ::: "memory")
#define PG8_WAIT_L(n) asm volatile("s_waitcnt lgkmcnt(" #n ")" ::: "memory")
#define PG8_BAR __builtin_amdgcn_s_barrier()
#define PG8_SCHED __builtin_amdgcn_sched_barrier(0)
    Unit cur, nxt; int ui = 0;
    if (!S.next(0, cur)) return;
    f32x4 acc[2][2][4][2];
#pragma unroll
    for (int a = 0; a < 2; ++a)
#pragma unroll
        for (int b = 0; b < 2; ++b)
#pragma unroll
            for (int m = 0; m < 4; ++m)
#pragma unroll
                for (int n = 0; n < 2; ++n) acc[a][b][m][n] = (f32x4){0.f, 0.f, 0.f, 0.f};
    bf16x8 At[4][2], B0[2][2], B1[2][2];
    const char* cA = g.apanel(cur.pm, tstep); const char* cB = (const char*)g.Bt + (size_t)cur.pn * tstep;
    S.a_ready(cur);
    if constexpr (SP2) {
        PG8_STAGE(PG8_SB(0, 0), cB, voffB); PG8_STAGE(PG8_SB(0, 1), cB + hstep, voffB); PG8_STAGE(PG8_SA(0, 0), cA, voffA); PG8_STAGE(PG8_SA(0, 1), cA + hstep, voffA);
        if (wr == 1) PG8_BAR;
        PG8_WAIT_V(2); PG8_BAR;
        PG8_STAGE(PG8_SB(1, 0), cB + kstep, voffB); PG8_STAGE(PG8_SA(1, 0), cA + kstep, voffA); PG8_STAGE(PG8_SB(1, 1), cB + hstep + kstep, voffB);
        PG8_WAIT_V(6); PG8_BAR;
    } else {
        PG8_STAGE(PG8_SB(0, 0), cB, voffB); PG8_STAGE(PG8_SA(0, 0), cA, voffA); PG8_STAGE(PG8_SB(0, 1), cB + hstep, voffB); PG8_STAGE(PG8_SA(0, 1), cA + hstep, voffA);
        if (wr == 1) PG8_BAR;
        PG8_WAIT_V(4); PG8_BAR;
        PG8_STAGE(PG8_SB(1, 0), cB + kstep, voffB); PG8_STAGE(PG8_SA(1, 0), cA + kstep, voffA); PG8_STAGE(PG8_SB(1, 1), cB + hstep + kstep, voffB);
        PG8_WAIT_V(6); PG8_BAR;
    }
    for (;;) {
        const bool has_next = S.next(ui + 1, nxt);
        const char* nA = has_next ? g.apanel(nxt.pm, tstep) : cA; const char* nB = has_next ? (const char*)g.Bt + (size_t)nxt.pn * tstep : cB;
        for (int seg = 0; seg < (Epi::KSEG ? 3 : 1); ++seg) {
        if constexpr (Epi::KSEG) { if (seg > 0) E.kscale(acc, seg, cur, wr, fr); }
        const int tb_ = Epi::KSEG ? (seg == 0 ? 0 : (seg == 1 ? 8 : 12)) : 0, te_ = Epi::KSEG ? (seg == 0 ? 8 : (seg == 1 ? 12 : nt)) : nt;
#pragma unroll 1
        for (int t = tb_; t < te_; t += 2) {
            const bool last = (t == nt - 2);
            const char* a1 = cA + (size_t)(t + 1) * kstep;
            const char* a2 = last ? nA : cA + (size_t)(t + 2) * kstep; const char* b2 = last ? nB : cB + (size_t)(t + 2) * kstep;
            const char* a3 = a2 + kstep; const char* b3 = b2 + kstep;
            if (last && has_next) S.a_ready(nxt);
            if constexpr (SP2) {
            PG8_LDB(B0, 0, 0); PG8_LDB(B1, 0, 1); PG8_SCHED; PG8_LDA(At, 0, 0); PG8_STAGE(PG8_SA(1, 1), a1 + hstep, voffA);
            PG8_WAIT_V(8); PG8_WAIT_L(0); PG8_BAR; PG8_MMA(0, 0, At, B0); PG8_MMA(0, 1, At, B1); PG8_BAR; PG8_SCHED;
            PG8_LDA(At, 0, 1); PG8_STAGE(PG8_SB(0, 0), b2, voffB); PG8_STAGE(PG8_SB(0, 1), b2 + hstep, voffB); PG8_STAGE(PG8_SA(0, 0), a2, voffA);
            PG8_WAIT_V(8); PG8_WAIT_L(0); PG8_BAR; PG8_MMA(1, 0, At, B0); PG8_MMA(1, 1, At, B1); PG8_BAR; PG8_SCHED;
            PG8_LDB(B0, 1, 0); PG8_LDB(B1, 1, 1); PG8_SCHED; PG8_LDA(At, 1, 0); PG8_STAGE(PG8_SA(0, 1), a2 + hstep, voffA);
            PG8_WAIT_V(8); PG8_WAIT_L(0); PG8_BAR; PG8_MMA(0, 0, At, B0); PG8_MMA(0, 1, At, B1); PG8_BAR; PG8_SCHED;
            PG8_LDA(At, 1, 1); PG8_STAGE(PG8_SB(1, 0), b3, voffB); PG8_STAGE(PG8_SB(1, 1), b3 + hstep, voffB); PG8_STAGE(PG8_SA(1, 0), a3, voffA);
            PG8_WAIT_V(8); PG8_WAIT_L(0); PG8_BAR; PG8_MMA(1, 0, At, B0); PG8_MMA(1, 1, At, B1); PG8_BAR; PG8_SCHED;
            } else {
            PG8_LDB(B0, 0, 0); PG8_SCHED; PG8_LDA(At, 0, 0); PG8_STAGE(PG8_SA(1, 1), a1 + hstep, voffA);
            PG8_WAIT_L(8); PG8_BAR; PG8_WAIT_L(0); PG8_MMA(0, 0, At, B0); PG8_BAR; PG8_SCHED;
            PG8_LDB(B1, 0, 1); PG8_STAGE(PG8_SB(0, 0), b2, voffB);
            PG8_BAR; PG8_WAIT_L(0); PG8_MMA(0, 1, At, B1); PG8_BAR;
            PG8_LDA(At, 0, 1); PG8_STAGE(PG8_SA(0, 0), a2, voffA);
            PG8_BAR; PG8_WAIT_L(0); PG8_MMA(1, 0, At, B0); PG8_BAR; PG8_SCHED;
            PG8_STAGE(PG8_SB(0, 1), b2 + hstep, voffB);
            PG8_WAIT_V(6); PG8_BAR; PG8_MMA(1, 1, At, B1); PG8_BAR;
            PG8_LDB(B0, 1, 0); PG8_SCHED; PG8_LDA(At, 1, 0); PG8_STAGE(PG8_SA(0, 1), a2 + hstep, voffA);
            PG8_WAIT_L(8); PG8_BAR; PG8_WAIT_L(0); PG8_MMA(0, 0, At, B0); PG8_BAR; PG8_SCHED;
            PG8_LDB(B1, 1, 1); PG8_STAGE(PG8_SB(1, 0), b3, voffB);
            PG8_BAR; PG8_WAIT_L(0); PG8_MMA(0, 1, At, B1); PG8_BAR;
            PG8_LDA(At, 1, 1); PG8_STAGE(PG8_SA(1, 0), a3, voffA);
            PG8_BAR; PG8_WAIT_L(0); PG8_MMA(1, 0, At, B0); PG8_BAR; PG8_SCHED;
            PG8_STAGE(PG8_SB(1, 1), b3 + hstep, voffB);
            PG8_WAIT_V(6); PG8_BAR; PG8_MMA(1, 1, At, B1); PG8_BAR;
            }
        }
        }
        if constexpr (ALIGN_EPI) { if (wr == 0) PG8_BAR; }
        if constexpr (!Epi::AFTER_DRAIN) { E(acc, cur, wr, wc, fr, fq); S.done(cur); }
        if (!has_next) break;
#pragma unroll
        for (int a = 0; a < 2; ++a)
#pragma unroll
            for (int b = 0; b < 2; ++b)
#pragma unroll
                for (int m = 0; m < 4; ++m)
#pragma unroll
                    for (int n = 0; n < 2; ++n) acc[a][b][m][n] = (f32x4){0.f, 0.f, 0.f, 0.f};
        cur = nxt; cA = nA; cB = nB; ++ui;
        if constexpr (ALIGN_EPI) { if (wr == 1) PG8_BAR; }
    }
    PG8_WAIT_V(0);
    if constexpr (!ALIGN_EPI) { if (wr == 0) PG8_BAR; }
    PG8_BAR;
    if constexpr (Epi::AFTER_DRAIN) { E.fused(acc, cur, wr, wc, fr, fq, lds, wid, lane); S.done(cur); }
#undef PG8_SA
#undef PG8_SB
#undef PG8_STAGE
#undef PG8_LDA
#undef PG8_LDB
#undef PG8_MMA
#undef PG8_WAIT_V
#undef PG8_WAIT_L
#undef PG8_BAR
#undef PG8_SCHED
}
}

#define DI __device__ __forceinline__
#define LAS __attribute__((address_space(3)))
typedef unsigned short bf16;
typedef short v8s __attribute__((ext_vector_type(8)));
typedef float v4f __attribute__((ext_vector_type(4)));
typedef float v16f __attribute__((ext_vector_type(16)));
typedef unsigned v4u __attribute__((ext_vector_type(4)));
typedef unsigned v2u __attribute__((ext_vector_type(2)));
typedef float f32x2_t __attribute__((ext_vector_type(2)));
typedef __bf16 bf16x2_t __attribute__((ext_vector_type(2)));

constexpr int BATCH = 8, SEQ = 4096, DMODEL = 1024, DEPTH = 4, T = BATCH * SEQ;
constexpr int NPROJ = 2048;
constexpr int C_SWAQ = 0, C_SWAK = 512, C_SWAV = 640, C_FOXQ = 768, C_FOXK = 1024, C_FOXV = 1280, C_CQ = 1536, C_CKV = 1792, C_KR = 1920, C_FL = 1952;
constexpr int DFF = 2816, NUP = 5632, IN_COLS = 1956;
constexpr float LOG2E = 1.4426950408889634f;
constexpr float C64 = 0.125f * LOG2E;
constexpr float C96 = 0.10206207261596575f * LOG2E;
constexpr float EPS = 1e-6f;
constexpr float NEGBIG = -1e30f;

constexpr size_t MiB = 1u << 20;
constexpr size_t WS_ROPE = 0, WS_BTAB = MiB / 2, WS_CWP = 1 * MiB, WS_RSTDX = MiB + MiB / 2, WS_SSQY = 16 * MiB, WS_SSQG = 18 * MiB, WS_FLOC = 3 * MiB, WS_FTOT = 3 * MiB + MiB / 2, WS_KNMAX = 3 * MiB + MiB / 2 + 65536, WS_GSIDE = 4 * MiB;
constexpr size_t WS_W = 20 * MiB, W_LAYER = 23 * MiB, WO_IN = 0, WO_OUT = 4 * MiB, WO_UP = 6 * MiB, WO_DOWN = 17 * MiB, WO_UQ = 22 * MiB + MiB / 2, WO_UKV = 22 * MiB + 3 * (MiB / 4);
constexpr size_t WS_HB = 112 * MiB, WS_R1 = 176 * MiB;
constexpr size_t WS_PROJ = WS_R1, WS_QM = WS_R1 + 128 * MiB, WS_KM = WS_R1 + 152 * MiB, WS_VTS = WS_R1 + 176 * MiB, WS_VTF = WS_R1 + 184 * MiB, WS_VTM = WS_R1 + 200 * MiB;
constexpr size_t WS_A = WS_R1, WS_Y1 = WS_R1;
constexpr size_t WS_MIX = 392 * MiB, WS_Y2 = WS_MIX, WS_CTL = 456 * MiB, CTL_BYTES = 16384 + 4 * 2 * 2 * 128 * 256 + 4096, CTL_CNT_OFF = 16384, CTL_GRP_OFF = 16384 + 4 * 2 * 2 * 128 * 256, CTL_FLAG_OFF = 15872, WS_SLOT2 = 457 * MiB, WS_END = 459 * MiB;

constexpr int RING_BYTES = 131072, HALO_OFF = RING_BYTES + 1024, LDS_BYTES = 147456, MISC_OFF = LDS_BYTES - 256;

DI unsigned pk2(float lo, float hi) { f32x2_t v = {lo, hi}; bf16x2_t b = __builtin_convertvector(v, bf16x2_t); return __builtin_bit_cast(unsigned, b); }
DI float bf2f(unsigned short u) { return __uint_as_float((unsigned)u << 16); }
DI float bflo(unsigned u) { return __uint_as_float(u << 16); }
DI float bfhi(unsigned u) { return __uint_as_float(u & 0xffff0000u); }
DI float max3f(float a, float b, float c) { float r; asm("v_max3_f32 %0, %1, %2, %3" : "=v"(r) : "v"(a), "v"(b), "v"(c)); return r; }
DI float max2f(float a, float b) { float r; asm("v_max_f32_e32 %0, %1, %2" : "=v"(r) : "v"(a), "v"(b)); return r; }
DI float fma_s(float a, float b, float c) { float r; asm("v_fma_f32 %0, %1, %2, %3" : "=v"(r) : "v"(a), "v"(b), "v"(c)); return r; }
DI int crow(int r, int hi) { return (r & 3) + 8 * (r >> 2) + 4 * hi; }
DI int hw_lane() { int l; asm volatile("v_mbcnt_lo_u32_b32 %0, -1, 0\n\tv_mbcnt_hi_u32_b32 %0, -1, %0" : "=v"(l)); return l; }
DI float wave_sum(float v) {
#pragma unroll
    for (int o = 1; o < 64; o <<= 1) v += __shfl_xor(v, o);
    return v;
}
DI float gelu_tanh(float x) {
    constexpr float C1 = -2.0f * 0.7978845608028654f * LOG2E, C2 = C1 * 0.044715f;
    const float e = __builtin_amdgcn_exp2f(x * __builtin_fmaf(x * x, C2, C1));
    return x * __builtin_amdgcn_rcpf(1.0f + e);
}
template <int CTRL> DI float dppf(float v) { return __int_as_float(__builtin_amdgcn_mov_dpp(__float_as_int(v), CTRL, 0xf, 0xf, true)); }

__device__ __forceinline__ void xcd_local_barrier(unsigned* ctr, unsigned epoch, int xtid) {
    asm volatile("s_waitcnt vmcnt(0)" ::: "memory");
    __syncthreads();
    if (xtid == 0) {
        __builtin_amdgcn_s_waitcnt(0);
        const unsigned target = (epoch + 1u) * 32u;
        (void)__hip_atomic_fetch_add(ctr, 1u, __ATOMIC_RELAXED, __HIP_MEMORY_SCOPE_AGENT);
        unsigned sp = 0u;
        while (__hip_atomic_load(ctr, __ATOMIC_RELAXED, __HIP_MEMORY_SCOPE_AGENT) < target) { if (++sp > (1u << 24)) break; }
        __builtin_amdgcn_fence(__ATOMIC_ACQUIRE, "agent");
        asm volatile("s_waitcnt vmcnt(0)" ::: "memory");
    }
    __syncthreads();
}

struct Args { const float* in[19]; float* out; unsigned char* ws; int ph_lo, ph_hi, coop, pad; };
typedef const __attribute__((address_space(4))) Args* AP;
enum { I_X = 0, I_APRE, I_WIN, I_FB, I_SINK, I_RELB, I_QLN, I_WUQ, I_KVLN, I_WUKV, I_GN, I_WOUT, I_APOST, I_FPRE, I_WUP, I_CW, I_CB, I_WDOWN, I_FPOST };


template <bool KSEG_> struct EpiY {
    static constexpr bool PERM = true, AFTER_DRAIN = false, KSEG = KSEG_;
    bf16* Y; float* ssq; const float* ssqg; LAS unsigned char* fsl;
    DI void kprep(const pg8::Unit& u, int wid, int wr, int fr, int fq) const {
        LAS float* F = (LAS float*)fsl + wid * 384;
#pragma unroll
        for (int j = 0; j < 2; ++j) {
            const int idx = 2 * fq + j, ai = idx >> 2, m = idx & 3;
            const int row = u.pm * 256 + ai * 128 + wr * 64 + m * 16 + fr;
            const v4f s0 = *(const v4f*)(ssqg + (size_t)row * 16), s1 = *(const v4f*)(ssqg + (size_t)row * 16 + 4), s2 = *(const v4f*)(ssqg + (size_t)row * 16 + 8), s3 = *(const v4f*)(ssqg + (size_t)row * 16 + 12);
            const float qa = ((s0[0] + s0[1]) + (s0[2] + s0[3])) + ((s1[0] + s1[1]) + (s1[2] + s1[3])), qb = (s2[0] + s2[1]) + (s2[2] + s2[3]), qc = (s3[0] + s3[1]) + (s3[2] + s3[3]);
            const float vb = qb * (1.0f / 256.0f) + EPS, vc = qc * (1.0f / 256.0f) + EPS;
            const float ra = rsqrtf(qa * (1.0f / 512.0f) + EPS), rb = rsqrtf(vb), rc = rsqrtf(vc);
            const int r = ai * 64 + m * 16 + fr;
            F[r] = ra * (vb * rb); F[128 + r] = rb * (vc * rc); F[256 + r] = rc;
            asm volatile("" ::: "memory");
        }
    }
    DI void kscale(pg8::f32x4 (&acc)[2][2][4][2], int seg, int wid, int fr) const {
        const LAS float* F = (const LAS float*)fsl + wid * 384 + ((seg == 1) ? 0 : 128);
#pragma unroll
        for (int ai = 0; ai < 2; ++ai)
#pragma unroll
            for (int m = 0; m < 4; ++m) {
                const float f = F[ai * 64 + m * 16 + fr];
#pragma unroll
                for (int bj = 0; bj < 2; ++bj)
#pragma unroll
                    for (int n = 0; n < 2; ++n) acc[ai][bj][m][n] = acc[ai][bj][m][n] * f;
            }
    }
    DI void operator()(const pg8::f32x4 (&acc)[2][2][4][2], const pg8::Unit& u, int wr, int wc, int fr, int fq) const {
        const LAS float* F = (const LAS float*)fsl + (wr * 4 + wc) * 384 + 256;
#pragma unroll
        for (int ai = 0; ai < 2; ++ai)
#pragma unroll
            for (int m = 0; m < 4; ++m) {
                const int row = u.pm * 256 + ai * 128 + wr * 64 + m * 16 + fr;
                float sc = 1.f; if (KSEG) sc = F[ai * 64 + m * 16 + fr];
                float q = 0.f;
#pragma unroll
                for (int bj = 0; bj < 2; ++bj) {
                    const pg8::f32x4 v0 = acc[ai][bj][m][0] * sc, v1 = acc[ai][bj][m][1] * sc;
                    q += (v0[0] * v0[0] + v0[1] * v0[1]) + (v0[2] * v0[2] + v0[3] * v0[3]) + (v1[0] * v1[0] + v1[1] * v1[1]) + (v1[2] * v1[2] + v1[3] * v1[3]);
                    v4u w; w.x = pk2(v0[0], v0[1]); w.y = pk2(v0[2], v0[3]); w.z = pk2(v1[0], v1[1]); w.w = pk2(v1[2], v1[3]);
                    *(v4u*)(Y + (size_t)row * 1024 + u.pn * 256 + bj * 128 + wc * 32 + 8 * fq) = w;
                }
                q += __shfl_xor(q, 16); q += __shfl_xor(q, 32);
                if (fq == 0) ssq[(size_t)row * 16 + u.pn * 4 + wc] = q;
            }
    }
};

struct EpiProj {
    static constexpr bool PERM = true, AFTER_DRAIN = false, KSEG = false;
    bf16* O; const float* rstdx;
    DI void operator()(const pg8::f32x4 (&acc)[2][2][4][2], const pg8::Unit& u, int wr, int wc, int fr, int fq) const {
#pragma unroll
        for (int ai = 0; ai < 2; ++ai)
#pragma unroll
            for (int m = 0; m < 4; ++m) {
                const int row = u.pm * 256 + ai * 128 + wr * 64 + m * 16 + fr; const float rs = rstdx[row];
#pragma unroll
                for (int bj = 0; bj < 2; ++bj) {
                    const pg8::f32x4 v0 = acc[ai][bj][m][0] * rs, v1 = acc[ai][bj][m][1] * rs;
                    v4u w; w.x = pk2(v0[0], v0[1]); w.y = pk2(v0[2], v0[3]); w.z = pk2(v1[0], v1[1]); w.w = pk2(v1[2], v1[3]);
                    *(v4u*)(O + (size_t)row * NPROJ + u.pn * 256 + bj * 128 + wc * 32 + 8 * fq) = w;
                }
            }
    }
};
template <class Sched> DI void row_scales(const Sched& S, const float* slots2, float* rstdx, int tid) {
    pg8::Unit u;
    {
        for (int i = tid >> 8; S.next(i, u); i += 2) {
            const size_t row = (size_t)u.pm * 256 + (tid & 255);
            const v4f s0 = *(const v4f*)(slots2 + row * 16), s1 = *(const v4f*)(slots2 + row * 16 + 4), s2 = *(const v4f*)(slots2 + row * 16 + 8), s3 = *(const v4f*)(slots2 + row * 16 + 12);
            const float s = (((s0[0] + s0[1]) + (s0[2] + s0[3])) + ((s1[0] + s1[1]) + (s1[2] + s1[3]))) + (((s2[0] + s2[1]) + (s2[2] + s2[3])) + ((s3[0] + s3[1]) + (s3[2] + s3[3])));
            rstdx[row] = rsqrtf(s * (1.0f / 1024.0f) + EPS);
        }
    }
    asm volatile("s_waitcnt vmcnt(0)" ::: "memory");
    __syncthreads();
}

DI bf16* a_row(unsigned char* ws, int row) {
    const int gb = row >> 12, s = row & 4095;
    return (bf16*)(s < 2816 ? ws + WS_PROJ + ((size_t)gb << 24) + (size_t)s * (DFF * 2) : ws + WS_MIX + ((size_t)gb << 23) + (size_t)(s - 2816) * (DFF * 2));
}
struct EpiConv {
    static constexpr bool PERM = true, AFTER_DRAIN = false, KSEG = false;
    unsigned char* wsb; const float* cwp; float* gside; LAS unsigned char* halo; const float* rstdx;
    DI void operator()(pg8::f32x4 (&acc)[2][2][4][2], const pg8::Unit& u, int wr, int wc, int fr, int fq) const {
        LAS v4f* H = (LAS v4f*)halo;
#pragma unroll
        for (int ai = 0; ai < 2; ++ai)
#pragma unroll
            for (int m = 0; m < 4; ++m) {
                const float rs = rstdx[u.pm * 256 + ai * 128 + wr * 64 + m * 16 + fr];
#pragma unroll
                for (int bj = 0; bj < 2; ++bj)
#pragma unroll
                    for (int n = 0; n < 2; ++n) acc[ai][bj][m][n] = acc[ai][bj][m][n] * rs;
            }
        const int hl = (fr & 1) + 2 * fq;
        if (fr >= 14) {
#pragma unroll
            for (int ai = 0; ai < 2; ++ai)
#pragma unroll
                for (int bj = 0; bj < 2; ++bj)
#pragma unroll
                    for (int n = 0; n < 2; ++n) { const pg8::f32x4 v = acc[ai][bj][3][n]; H[(((ai * 2 + wr) * 4 + wc) * 4 + bj * 2 + n) * 8 + hl] = (v4f){v[0], v[1], v[2], v[3]}; }
        }
        if (wr == 1 && fr >= 14) {
#pragma unroll
            for (int bj = 0; bj < 2; ++bj)
#pragma unroll
                for (int n = 0; n < 2; ++n) { const pg8::f32x4 v = acc[1][bj][3][n]; *(v4f*)(gside + (size_t)(u.pm * 4 + 2 + (fr - 14)) * NUP + u.pn * 256 + bj * 128 + wc * 32 + 8 * fq + 4 * n) = (v4f){v[0], v[1], v[2], v[3]}; }
        }
        if (wr == 0 && fr < 2) {
#pragma unroll
            for (int bj = 0; bj < 2; ++bj)
#pragma unroll
                for (int n = 0; n < 2; ++n) { const pg8::f32x4 v = acc[0][bj][0][n]; *(v4f*)(gside + (size_t)(u.pm * 4 + fr) * NUP + u.pn * 256 + bj * 128 + wc * 32 + 8 * fq + 4 * n) = (v4f){v[0], v[1], v[2], v[3]}; }
        }
        asm volatile("s_waitcnt lgkmcnt(0)\n\ts_barrier" ::: "memory");
#pragma unroll
        for (int n = 0; n < 2; ++n) {
            v4f w0[2], w1[2], w2[2], cb[2];
#pragma unroll
            for (int bj = 0; bj < 2; ++bj) {
                const float* p = cwp + u.pn * 256 + bj * 128 + wc * 32 + 8 * fq + 4 * n;
                w0[bj] = *(const v4f*)p; w1[bj] = *(const v4f*)(p + NUP); w2[bj] = *(const v4f*)(p + 2 * NUP); cb[bj] = *(const v4f*)(p + 3 * NUP);
            }
#pragma unroll
            for (int ai = 0; ai < 2; ++ai) {
                v4f hal[2];
                {
                    const bool has = (wr == 1) || (ai == 1);
                    const int as = (wr == 1) ? ai : 0, ws_ = (wr == 1) ? 0 : 1;
#pragma unroll
                    for (int bj = 0; bj < 2; ++bj) { v4f hv = H[(((as * 2 + ws_) * 4 + wc) * 4 + bj * 2 + n) * 8 + hl]; hal[bj] = has ? hv : (v4f){0.f, 0.f, 0.f, 0.f}; }
                }
#pragma unroll
                for (int m = 0; m < 4; ++m) {
                    float cv[2][4];
#pragma unroll
                    for (int bj = 0; bj < 2; ++bj) {
                        const pg8::f32x4 cur = acc[ai][bj][m][n];
                        pg8::f32x4 prv;
                        if (m > 0) prv = acc[ai][bj][m > 0 ? m - 1 : 0][n]; else prv = (pg8::f32x4){hal[bj][0], hal[bj][1], hal[bj][2], hal[bj][3]};
#pragma unroll
                        for (int i = 0; i < 4; ++i) {
                            const float q1 = dppf<0x121>(prv[i]), q2 = dppf<0x122>(prv[i]);
                            const float p1 = __int_as_float(__builtin_amdgcn_update_dpp(__float_as_int(q1), __float_as_int(cur[i]), 0x111, 0xf, 0xf, false));
                            const float p2 = __int_as_float(__builtin_amdgcn_update_dpp(__float_as_int(q2), __float_as_int(cur[i]), 0x112, 0xf, 0xf, false));
                            cv[bj][i] = cb[bj][i] + w0[bj][i] * p2 + w1[bj][i] * p1 + w2[bj][i] * cur[i];
                        }
                    }
                    float o[4];
#pragma unroll
                    for (int i = 0; i < 4; ++i) o[i] = gelu_tanh(cv[0][i]) * cv[1][i];
                    const int row = u.pm * 256 + ai * 128 + wr * 64 + m * 16 + fr;
                    v2u w; w.x = pk2(o[0], o[1]); w.y = pk2(o[2], o[3]);
                    *(v2u*)(a_row(wsb, row) + u.pn * 128 + wc * 32 + 8 * fq + 4 * n) = w;
                }
            }
        }
    }
};

#define XB_TMO      128
#define XB_XCNT(j)  (256  + 64 * (j))
#define XB_XSUB(j)  (1280 + 64 * (j))
#define XB_XGEN(j)  (2304 + 64 * (j))
#define XB_TOP      3328
#define XB_TOPGEN   3392
#define XCD_BAR_WORDS 3456
#define XB_SPIN_CAP (1u << 18)

__device__ __forceinline__ unsigned xb_ld(unsigned* p)              { return __hip_atomic_load(p, __ATOMIC_RELAXED, __HIP_MEMORY_SCOPE_AGENT); }
__device__ __forceinline__ unsigned xb_add(unsigned* p, unsigned v) { return __hip_atomic_fetch_add(p, v, __ATOMIC_RELAXED, __HIP_MEMORY_SCOPE_AGENT); }
__device__ __forceinline__ unsigned xb_xcc_id() { return (unsigned)__builtin_amdgcn_s_getreg((3 << 11) | 20) & 0xFu; }
#define XB_SPIN(cond, bar) do { unsigned _sp = 0; while (cond) { __builtin_amdgcn_s_sleep(1); \
    if ((++_sp & 255u) == 0u) { if (xb_ld(&(bar)[XB_TMO])) break; if (_sp > XB_SPIN_CAP) { atomicAdd(&(bar)[XB_TMO], 1u); break; } } } } while (0)

struct XcdBarrier {
    unsigned* bar; unsigned x;
    volatile LAS unsigned* st;
};

__device__ __forceinline__ XcdBarrier xcd_barrier_post(unsigned* bar, volatile LAS unsigned* st, int xtid) {
    XcdBarrier b; b.bar = bar; b.x = xb_xcc_id(); b.st = st;
    if (xtid == 0) (void)xb_add(&bar[XB_XCNT(b.x)], 1u);
    return b;
}
__device__ __forceinline__ void xcd_barrier_complete(unsigned* bar, unsigned x, unsigned& nloc, unsigned& nx) {
    const unsigned G = gridDim.x * gridDim.y * gridDim.z;
    unsigned sum, cnt, mine, sp = 0u;
    for (;;) {
        sum = 0u; cnt = 0u; mine = 0u;
#pragma unroll
        for (unsigned j = 0; j < 16; ++j) { const unsigned c = xb_ld(&bar[XB_XCNT(j)]); sum += c; cnt += (c > 0u) ? 1u : 0u; mine = (j == x) ? c : mine; }
        if (sum == G) break;
        __builtin_amdgcn_s_sleep(1);
        if ((++sp & 255u) == 0u) { if (xb_ld(&bar[XB_TMO])) break; if (sp > XB_SPIN_CAP) { atomicAdd(&bar[XB_TMO], 1u); break; } }
    }
    nloc = mine > 0u ? mine : 1u; nx = cnt > 0u ? cnt : 1u;
}

__device__ __forceinline__ void xcd_barrier(const XcdBarrier& b, int xtid) {
    asm volatile("s_waitcnt vmcnt(0)" ::: "memory");
    __syncthreads();
    if (xtid == 0) {
        unsigned* bar = b.bar;
        __builtin_amdgcn_s_waitcnt(0);
        unsigned nloc = b.st[0], nx = b.st[1];
        if (nloc == 0u) { xcd_barrier_complete(bar, b.x, nloc, nx); b.st[0] = nloc; b.st[1] = nx; }
        const unsigned old = xb_add(&bar[XB_XSUB(b.x)], 1u);
        const unsigned gen = old / nloc;
        if (old + 1u == (gen + 1u) * nloc) {
            __builtin_amdgcn_fence(__ATOMIC_RELEASE, "agent");
            asm volatile("s_waitcnt vmcnt(0)" ::: "memory");
            const unsigned og = xb_add(&bar[XB_TOP], 1u);
            const unsigned tg = og / nx;
            if (og + 1u == (tg + 1u) * nx) xb_add(&bar[XB_TOPGEN], 1u);
            else XB_SPIN(xb_ld(&bar[XB_TOPGEN]) == tg, bar);
            __builtin_amdgcn_fence(__ATOMIC_ACQUIRE, "agent");
            xb_add(&bar[XB_XGEN(b.x)], 1u);
            asm volatile("s_waitcnt vmcnt(0)" ::: "memory");
        } else {
            XB_SPIN(xb_ld(&bar[XB_XGEN(b.x)]) == gen, bar);
            __builtin_amdgcn_fence(__ATOMIC_ACQUIRE, "agent");
            asm volatile("s_waitcnt vmcnt(0)" ::: "memory");
        }
    }
    __syncthreads();
}

template <int MAP> DI int srccol(int n) {
    if (MAP == 0) return n;
    if (MAP == 1) return n < 1536 ? n : (n < 1952 ? n + 4 : (n < 1956 ? n - 416 : -1));
    if (MAP == 2) { const int pn = n >> 8, bj = (n >> 7) & 1, jj = n & 127; return bj * DFF + pn * 128 + jj; }
    { const int v = n >> 8, h = (n >> 6) & 3, j = n & 63; return h * 128 + v * 64 + j; }
}
template <int MAP> DI void cvt_item(const float* W, int K, int Nsrc, bf16* WT, int Ndst, const float* kgain, float scale, LAS float* scr, int item, int lane) {
    const int nblk = Ndst / 32, kb = item / nblk, nb = item % nblk, k0 = 64 * kb, n0 = 32 * nb;
    const int c4 = lane & 7, n4 = n0 + 4 * c4, sc = srccol<MAP>(n4);
    float cs = scale; if (MAP == 1) { cs = (n4 < 512 || (n4 >= 768 && n4 < 1024)) ? scale : 1.f; }
    v4f wv[8];
#pragma unroll
    for (int jx = 0; jx < 8; ++jx) { const int kk = (lane >> 3) + 8 * jx; wv[jx] = (sc >= 0) ? *(const v4f*)(W + (size_t)(k0 + kk) * Nsrc + sc) : (v4f){0.f, 0.f, 0.f, 0.f}; }
#pragma unroll
    for (int jx = 0; jx < 8; ++jx) {
        const int kk = (lane >> 3) + 8 * jx;
        float g = cs; if (kgain) g *= kgain[k0 + kk];
        LAS float* d = scr + kk * 33 + 4 * c4;
        d[0] = wv[jx][0] * g; d[1] = wv[jx][1] * g; d[2] = wv[jx][2] * g; d[3] = wv[jx][3] * g;
    }
    asm volatile("s_waitcnt lgkmcnt(0)" ::: "memory");
    const int c = lane & 7;
#pragma unroll
    for (int j = 0; j < 4; ++j) {
        const int nn = (lane >> 3) + 8 * j; const LAS float* s = scr + (8 * c) * 33 + nn;
        v4u o; o.x = pk2(s[0 * 33], s[1 * 33]); o.y = pk2(s[2 * 33], s[3 * 33]); o.z = pk2(s[4 * 33], s[5 * 33]); o.w = pk2(s[6 * 33], s[7 * 33]);
        *(v4u*)(WT + (size_t)(n0 + nn) * K + k0 + 8 * c) = o;
    }
    asm volatile("s_waitcnt lgkmcnt(0)" ::: "memory");
}

DI void row_update(float* xrow, const float* xin, const bf16* yrow, float* ssqp, const float* gpost, const float* gpre, bf16* hrow, int lane) {
    v4f v[4];
    const v4f* src = (const v4f*)(xin ? xin : xrow) + lane;
#pragma unroll
    for (int j = 0; j < 4; ++j) v[j] = src[64 * j];
    if (yrow) {
        const v4f s0 = *(const v4f*)ssqp, s1 = *(const v4f*)(ssqp + 4), s2 = *(const v4f*)(ssqp + 8), s3 = *(const v4f*)(ssqp + 12);
        const float sy = (((s0[0] + s0[1]) + (s0[2] + s0[3])) + ((s1[0] + s1[1]) + (s1[2] + s1[3]))) + (((s2[0] + s2[1]) + (s2[2] + s2[3])) + ((s3[0] + s3[1]) + (s3[2] + s3[3])));
        const float rsy = rsqrtf(sy * (1.0f / 1024.0f) + EPS);
        const v2u* yp = (const v2u*)yrow + lane;
#pragma unroll
        for (int j = 0; j < 4; ++j) {
            const v2u y = yp[64 * j]; const v4f g = ((const v4f*)gpost)[lane + 64 * j];
            v[j][0] += bflo(y.x) * rsy * g[0]; v[j][1] += bfhi(y.x) * rsy * g[1]; v[j][2] += bflo(y.y) * rsy * g[2]; v[j][3] += bfhi(y.y) * rsy * g[3];
        }
    }
    {
        v4f* dst = (v4f*)xrow + lane;
#pragma unroll
        for (int j = 0; j < 4; ++j) dst[64 * j] = v[j];
    }
    if (gpre) {
        float s = 0.f;
#pragma unroll
        for (int j = 0; j < 4; ++j) s += (v[j][0] * v[j][0] + v[j][1] * v[j][1]) + (v[j][2] * v[j][2] + v[j][3] * v[j][3]);
        const float rs = rsqrtf(wave_sum(s) * (1.0f / 1024.0f) + EPS);
        v2u* hp = (v2u*)hrow + lane;
#pragma unroll
        for (int j = 0; j < 4; ++j) {
            const v4f g = ((const v4f*)gpre)[lane + 64 * j];
            v2u w; w.x = pk2(v[j][0] * rs * g[0], v[j][1] * rs * g[1]); w.y = pk2(v[j][2] * rs * g[2], v[j][3] * rs * g[3]);
            hp[64 * j] = w;
        }
    }
}

struct RowExchange {
    float* slots; unsigned* cnt; unsigned* tmo;
    DI void run(const float (&part)[2][4], const pg8::Unit& u, int wr, int wc, int fr, int fq, int wid, int lane, LAS float* S, volatile LAS unsigned* flag) const {
        if (fq == 0) {
#pragma unroll
            for (int ai = 0; ai < 2; ++ai)
#pragma unroll
                for (int m = 0; m < 4; ++m) {
                    const int row = u.pm * 256 + ai * 128 + wr * 64 + m * 16 + fr;
                    __hip_atomic_store((unsigned*)slots + (size_t)row * 16 + u.pn * 4 + wc, __float_as_uint(part[ai][m]), __ATOMIC_RELAXED, __HIP_MEMORY_SCOPE_AGENT);
                }
        }
        asm volatile("s_waitcnt vmcnt(0)" ::: "memory");
        if (lane == 0) __hip_atomic_fetch_add(cnt + 64 * u.pm, 1u, __ATOMIC_RELAXED, __HIP_MEMORY_SCOPE_AGENT);
        if (wid == 0) {
            unsigned sp = 0;
            for (;;) {
                if ((unsigned)__builtin_amdgcn_readfirstlane(__hip_atomic_load(cnt + 64 * u.pm, __ATOMIC_RELAXED, __HIP_MEMORY_SCOPE_AGENT)) >= 32u) break;
                if (++sp > (1u << 22)) { if (lane == 0) __hip_atomic_store(tmo, 1u, __ATOMIC_RELAXED, __HIP_MEMORY_SCOPE_AGENT); break; }
            }
            __builtin_amdgcn_fence(__ATOMIC_ACQUIRE, "agent");
        }
        asm volatile("s_waitcnt vmcnt(0) lgkmcnt(0)" ::: "memory"); __builtin_amdgcn_s_barrier(); asm volatile("" ::: "memory");
        int ln = lane; asm volatile("" : "+v"(ln));
        if (ln < 32) {
            const int r = wid * 32 + ln;
            const unsigned* sl = (const unsigned*)slots + (size_t)(u.pm * 256 + r) * 16;
            float v[16];
#pragma unroll
            for (int k = 0; k < 16; ++k) v[k] = __uint_as_float(__hip_atomic_load(sl + k, __ATOMIC_RELAXED, __HIP_MEMORY_SCOPE_AGENT));
            const float s = (((v[0] + v[1]) + (v[2] + v[3])) + ((v[4] + v[5]) + (v[6] + v[7]))) + (((v[8] + v[9]) + (v[10] + v[11])) + ((v[12] + v[13]) + (v[14] + v[15])));
            S[r] = rsqrtf(s * (1.0f / 1024.0f) + EPS);
        }
        asm volatile("s_waitcnt lgkmcnt(0)" ::: "memory"); __builtin_amdgcn_s_barrier(); asm volatile("" ::: "memory");
    }
};
template <bool KSEG_> struct EpiRes {
    static constexpr bool PERM = true, AFTER_DRAIN = false, KSEG = KSEG_;
    AP a; int l; LAS unsigned char* fsl; int pm0, pn0;
    DI int ordinal(const pg8::Unit& u) const { return (u.pm == pm0 && u.pn == pn0) ? 0 : 1; }
    DI void kscale(pg8::f32x4 (&acc)[2][2][4][2], int seg, const pg8::Unit& u, int wr, int fr) const {
        const LAS float* F = (const LAS float*)fsl + (ordinal(u) * 3 + ((seg == 1) ? 0 : 1)) * 256 + wr * 64 + fr;
#pragma unroll
        for (int ai = 0; ai < 2; ++ai)
#pragma unroll
            for (int m = 0; m < 4; ++m) {
                const float f = F[ai * 128 + m * 16];
#pragma unroll
                for (int bj = 0; bj < 2; ++bj)
#pragma unroll
                    for (int n = 0; n < 2; ++n) acc[ai][bj][m][n] = acc[ai][bj][m][n] * f;
            }
    }
    DI void operator()(pg8::f32x4 (&acc)[2][2][4][2], const pg8::Unit& u, int wr, int wc, int fr, int fq) const {
        const int wid = wr * 4 + wc, lane = fr + 16 * fq;
        AP ap = a; asm volatile("" : "+s"(ap));
        unsigned char* ws = ap->ws; bf16* XB = (bf16*)(ws + WS_HB);
        const float* gpost = ap->in[KSEG ? I_APOST : I_FPOST] + l * 1024;
        const bool last = (!KSEG) && (l + 1 == DEPTH);
        float* OUT = ap->out;
        unsigned* cb = (unsigned*)(ws + WS_CTL + CTL_CNT_OFF) + (size_t)(l * 4 + (KSEG ? 0 : 2)) * 128 * 64;
        const RowExchange ex1{(float*)(ws + WS_SSQY), cb, (unsigned*)(ws + WS_CTL) + XB_TMO};
        float* slots2 = (float*)(ws + WS_SLOT2);
        LAS unsigned char* xl = fsl + 12288;
        LAS float* S = (LAS float*)xl; volatile LAS unsigned* flag = (volatile LAS unsigned*)(xl + 1024);
        float part[2][4];
#pragma unroll
        for (int ai = 0; ai < 2; ++ai)
#pragma unroll
            for (int m = 0; m < 4; ++m) {
                if (KSEG) { const float sc = ((const LAS float*)fsl)[(ordinal(u) * 3 + 2) * 256 + ai * 128 + wr * 64 + m * 16 + fr];
#pragma unroll
                    for (int bj = 0; bj < 2; ++bj)
#pragma unroll
                        for (int n = 0; n < 2; ++n) acc[ai][bj][m][n] = acc[ai][bj][m][n] * sc; }
                float q = 0.f;
#pragma unroll
                for (int bj = 0; bj < 2; ++bj)
#pragma unroll
                    for (int n = 0; n < 2; ++n) { const pg8::f32x4 v = acc[ai][bj][m][n]; q += (v[0] * v[0] + v[1] * v[1]) + (v[2] * v[2] + v[3] * v[3]); }
                q += __shfl_xor(q, 16); q += __shfl_xor(q, 32);
                part[ai][m] = q;
            }
        ex1.run(part, u, wr, wc, fr, fq, wid, lane, S, flag);
        const int colb = u.pn * 256 + wc * 32 + 8 * fq;
#pragma unroll
        for (int ai = 0; ai < 2; ++ai)
#pragma unroll
            for (int m = 0; m < 4; ++m) {
                const int rl = ai * 128 + wr * 64 + m * 16 + fr; const float r1 = S[rl];
                const size_t ro = (size_t)(u.pm * 256 + rl) * 1024 + colb;
                float q = 0.f;
#pragma unroll
                for (int bj = 0; bj < 2; ++bj) {
                    const v4u xw = *(const v4u*)(XB + ro + bj * 128);
                    const v4f g0 = *(const v4f*)(gpost + colb + bj * 128), g1 = *(const v4f*)(gpost + colb + bj * 128 + 4);
                    const pg8::f32x4 a0 = acc[ai][bj][m][0], a1 = acc[ai][bj][m][1];
                    float v[8];
                    v[0] = bflo(xw.x) + a0[0] * r1 * g0[0]; v[1] = bfhi(xw.x) + a0[1] * r1 * g0[1]; v[2] = bflo(xw.y) + a0[2] * r1 * g0[2]; v[3] = bfhi(xw.y) + a0[3] * r1 * g0[3];
                    v[4] = bflo(xw.z) + a1[0] * r1 * g1[0]; v[5] = bfhi(xw.z) + a1[1] * r1 * g1[1]; v[6] = bflo(xw.w) + a1[2] * r1 * g1[2]; v[7] = bfhi(xw.w) + a1[3] * r1 * g1[3];
                    q += ((v[0] * v[0] + v[1] * v[1]) + (v[2] * v[2] + v[3] * v[3])) + ((v[4] * v[4] + v[5] * v[5]) + (v[6] * v[6] + v[7] * v[7]));
                    if (last) { *(v4f*)(OUT + ro + bj * 128) = (v4f){v[0], v[1], v[2], v[3]}; *(v4f*)(OUT + ro + bj * 128 + 4) = (v4f){v[4], v[5], v[6], v[7]}; }
                    else { v4u w; w.x = pk2(v[0], v[1]); w.y = pk2(v[2], v[3]); w.z = pk2(v[4], v[5]); w.w = pk2(v[6], v[7]); *(v4u*)(XB + ro + bj * 128) = w; }
                }
                q += __shfl_xor(q, 16); q += __shfl_xor(q, 32);
                if (fq == 0) slots2[(size_t)(u.pm * 256 + rl) * 16 + u.pn * 4 + wc] = q;
                if (m & 1) asm volatile("" ::: "memory");
            }
        asm volatile("s_waitcnt lgkmcnt(0)" ::: "memory"); __builtin_amdgcn_s_barrier(); asm volatile("" ::: "memory");
    }
};

DI void seam_factors(const float* ssqg, int pm, LAS float* F, int tid) {
    if (tid < 256) {
        const size_t row = (size_t)pm * 256 + tid;
        const v4f s0 = *(const v4f*)(ssqg + row * 16), s1 = *(const v4f*)(ssqg + row * 16 + 4), s2 = *(const v4f*)(ssqg + row * 16 + 8), s3 = *(const v4f*)(ssqg + row * 16 + 12);
        const float qa = ((s0[0] + s0[1]) + (s0[2] + s0[3])) + ((s1[0] + s1[1]) + (s1[2] + s1[3])), qb = (s2[0] + s2[1]) + (s2[2] + s2[3]), qc = (s3[0] + s3[1]) + (s3[2] + s3[3]);
        const float vb = qb * (1.0f / 256.0f) + EPS, vc = qc * (1.0f / 256.0f) + EPS;
        const float ra = rsqrtf(qa * (1.0f / 512.0f) + EPS), rb = rsqrtf(vb), rc = rsqrtf(vc);
        F[tid] = ra * (vb * rb); F[256 + tid] = rb * (vc * rc); F[512 + tid] = rc;
    }
}

#define MFMA32(a, b, c) __builtin_amdgcn_mfma_f32_32x32x16_bf16((a), (b), (c), 0, 0, 0)

DI void prep_unit(AP a, int l, int unit, LAS unsigned char* lds, int tid, int lane, int wave) {
    unsigned char* ws = a->ws;
    const bf16* proj = (const bf16*)(ws + WS_PROJ);
    const bf16* Wuq = (const bf16*)(ws + WS_W + (size_t)l * W_LAYER + WO_UQ);
    const bf16* Wukv = (const bf16*)(ws + WS_W + (size_t)l * W_LAYER + WO_UKV);
    bf16* qm = (bf16*)(ws + WS_QM); bf16* km = (bf16*)(ws + WS_KM);
    bf16* vts = (bf16*)(ws + WS_VTS); bf16* vtf = (bf16*)(ws + WS_VTF); bf16* vtm = (bf16*)(ws + WS_VTM);
    const float* rope = (const float*)(ws + WS_ROPE);
    const int t0 = unit * 128, b = t0 / SEQ, s0 = t0 % SEQ;
    const int rb = wave & 3, half = wave >> 2, r32 = lane & 31, hi = lane >> 5;
    const int row = t0 + 32 * rb + r32, pos = s0 + 32 * rb + r32;
    {
        constexpr int WSZ = 32 * 528;
        LAS unsigned char* wb = lds + 1024 + half * 2 * WSZ;
        const int ht = tid & 255;
        v8s bq[16], bk[8]; float ssq_ = 0.f, ssk_ = 0.f;
#pragma unroll
        for (int ks = 0; ks < 16; ++ks) {
            bq[ks] = *(const v8s*)(proj + (size_t)row * NPROJ + C_CQ + 16 * ks + 8 * hi);
#pragma unroll
            for (int jx = 0; jx < 8; ++jx) { const float f = bf2f((unsigned short)bq[ks][jx]); ssq_ += f * f; }
        }
#pragma unroll
        for (int ks = 0; ks < 8; ++ks) {
            bk[ks] = *(const v8s*)(proj + (size_t)row * NPROJ + C_CKV + 16 * ks + 8 * hi);
#pragma unroll
            for (int jx = 0; jx < 8; ++jx) { const float f = bf2f((unsigned short)bk[ks][jx]); ssk_ += f * f; }
        }
        ssq_ += __shfl_xor(ssq_, 32); ssk_ += __shfl_xor(ssk_, 32);
        const float rstdq = rsqrtf(ssq_ * (1.0f / 256.0f) + EPS), rstdk = rsqrtf(ssk_ * (1.0f / 128.0f) + EPS);
        v4u wreg[4];
#define PW_LOAD(st) do { if ((st) < 6) { const bf16* src_ = Wuq + (size_t)(32 * (half * 6 + (st))) * 256; \
            _Pragma("unroll") for (int jx = 0; jx < 4; ++jx) { const int p_ = ht + 256 * jx; wreg[jx] = *(const v4u*)(src_ + (size_t)(p_ >> 5) * 256 + 8 * (p_ & 31)); } } \
        else { const bf16* src_ = Wukv + (size_t)(32 * (half * 8 + (st) - 6)) * 128; \
            _Pragma("unroll") for (int jx = 0; jx < 2; ++jx) { const int p_ = ht + 256 * jx; wreg[jx] = *(const v4u*)(src_ + (size_t)(p_ >> 4) * 128 + 8 * (p_ & 15)); } } } while (0)
#define PW_STORE(st, bf_) do { LAS unsigned char* d_ = wb + (bf_) * WSZ; if ((st) < 6) { \
            _Pragma("unroll") for (int jx = 0; jx < 4; ++jx) { const int p_ = ht + 256 * jx; *(LAS v4u*)(d_ + (p_ >> 5) * 528 + 16 * (p_ & 31)) = wreg[jx]; } } \
        else { _Pragma("unroll") for (int jx = 0; jx < 2; ++jx) { const int p_ = ht + 256 * jx; *(LAS v4u*)(d_ + (p_ >> 4) * 528 + 16 * (p_ & 15)) = wreg[jx]; } } } while (0)
        __syncthreads();
        PW_LOAD(0); PW_STORE(0, 0);
        __syncthreads();
#pragma unroll 1
        for (int st = 0; st < 14; ++st) {
            if (st + 1 < 14) PW_LOAD(st + 1);
            const LAS unsigned char* wp = wb + (st & 1) * WSZ + r32 * 528 + 16 * hi;
            v16f acc = {};
            if (st < 6) {
                const int cb = half * 6 + st;
#pragma unroll
                for (int ks = 0; ks < 16; ++ks) { const v8s af = *(const LAS v8s*)(wp + 32 * ks); acc = MFMA32(af, bq[ks], acc); }
#pragma unroll
                for (int r = 0; r < 16; ++r) acc[r] *= rstdq;
                if (st % 3 == 2) {
                    const v4f c0 = *(const v4f*)(rope + (size_t)pos * 32 + 4 * hi), c1 = *(const v4f*)(rope + (size_t)pos * 32 + 8 + 4 * hi);
                    const v4f s0v = *(const v4f*)(rope + (size_t)pos * 32 + 16 + 4 * hi), s1v = *(const v4f*)(rope + (size_t)pos * 32 + 24 + 4 * hi);
#pragma unroll
                    for (int r = 0; r < 8; ++r) {
                        const float c = (r < 4) ? c0[r & 3] : c1[r & 3], s = (r < 4) ? s0v[r & 3] : s1v[r & 3];
                        const float x1 = acc[r], x2 = acc[r + 8];
                        acc[r] = x1 * c - x2 * s; acc[r + 8] = x1 * s + x2 * c;
                    }
                }
#pragma unroll
                for (int g = 0; g < 4; ++g) { v2u w; w.x = pk2(acc[4 * g], acc[4 * g + 1]); w.y = pk2(acc[4 * g + 2], acc[4 * g + 3]); *(v2u*)(qm + (size_t)row * 384 + 32 * cb + 8 * g + 4 * hi) = w; }
            } else {
                const int cbi = st - 6;
#pragma unroll
                for (int ks = 0; ks < 8; ++ks) { const v8s af = *(const LAS v8s*)(wp + 32 * ks); acc = MFMA32(af, bk[ks], acc); }
#pragma unroll
                for (int r = 0; r < 16; ++r) acc[r] *= rstdk;
                const int head = cbi >> 1, off = 32 * (cbi & 1);
                if (half == 0) {
#pragma unroll
                    for (int g = 0; g < 4; ++g) { v2u w; w.x = pk2(acc[4 * g], acc[4 * g + 1]); w.y = pk2(acc[4 * g + 2], acc[4 * g + 3]); *(v2u*)(km + (size_t)row * 384 + 96 * head + off + 8 * g + 4 * hi) = w; }
                } else {
#pragma unroll
                    for (int r = 0; r < 16; ++r) { const int d = off + crow(r, hi); vtm[((size_t)(b * 4 + head) * 64 + d) * SEQ + pos] = (bf16)(pk2(acc[r], 0.f) & 0xffffu); }
                }
            }
            if (st + 1 < 14) PW_STORE(st + 1, (st + 1) & 1);
            __syncthreads();
        }
#undef PW_LOAD
#undef PW_STORE
    }
    {
        const int rl = tid >> 2, q4 = tid & 3; const int rw = t0 + rl, ps = s0 + rl;
        const v2u x1 = *(const v2u*)(proj + (size_t)rw * NPROJ + C_KR + 4 * q4), x2 = *(const v2u*)(proj + (size_t)rw * NPROJ + C_KR + 16 + 4 * q4);
        const v4f c = *(const v4f*)(rope + (size_t)ps * 32 + 4 * q4), s = *(const v4f*)(rope + (size_t)ps * 32 + 16 + 4 * q4);
        const float a1[4] = {bflo(x1.x), bfhi(x1.x), bflo(x1.y), bfhi(x1.y)}, a2[4] = {bflo(x2.x), bfhi(x2.x), bflo(x2.y), bfhi(x2.y)};
        float o1[4], o2[4];
#pragma unroll
        for (int i = 0; i < 4; ++i) { o1[i] = a1[i] * c[i] - a2[i] * s[i]; o2[i] = a1[i] * s[i] + a2[i] * c[i]; }
        v2u w1, w2; w1.x = pk2(o1[0], o1[1]); w1.y = pk2(o1[2], o1[3]); w2.x = pk2(o2[0], o2[1]); w2.y = pk2(o2[2], o2[3]);
#pragma unroll
        for (int h = 0; h < 4; ++h) { *(v2u*)(km + (size_t)rw * 384 + 96 * h + 64 + 4 * q4) = w1; *(v2u*)(km + (size_t)rw * 384 + 96 * h + 80 + 4 * q4) = w2; }
    }
#pragma unroll 4
    for (int k = 0; k < 12; ++k) {
        const int it = tid + 512 * k, c = it % 384, rg = it / 384;
        const int src = c < 128 ? C_SWAV + c : C_FOXV + (c - 128);
        unsigned short e[8];
#pragma unroll
        for (int j = 0; j < 8; ++j) e[j] = proj[(size_t)(t0 + 8 * rg + j) * NPROJ + src];
        v4u w; w.x = e[0] | ((unsigned)e[1] << 16); w.y = e[2] | ((unsigned)e[3] << 16); w.z = e[4] | ((unsigned)e[5] << 16); w.w = e[6] | ((unsigned)e[7] << 16);
        bf16* dst = c < 128 ? vts + ((size_t)(b * 2 + (c >> 6)) * 64 + (c & 63)) * SEQ : vtf + ((size_t)(b * 4 + ((c - 128) >> 6)) * 64 + ((c - 128) & 63)) * SEQ;
        *(v4u*)(dst + s0 + 8 * rg) = w;
    }
    {
        const int tk = tid >> 2, h = tid & 3;
        const v4u* kp = (const v4u*)(proj + (size_t)(t0 + tk) * NPROJ + C_FOXK + 64 * h);
        float ss = 0.f;
#pragma unroll
        for (int i = 0; i < 8; ++i) { const v4u w = kp[i]; const unsigned e[4] = {w.x, w.y, w.z, w.w};
#pragma unroll
            for (int j = 0; j < 4; ++j) { const float lo = bflo(e[j]), hi2 = bfhi(e[j]); ss += lo * lo + hi2 * hi2; } }
        float nm = sqrtf(ss);
#pragma unroll
        for (int o = 4; o < 64; o <<= 1) nm = fmaxf(nm, __shfl_xor(nm, o));
        LAS float* red = (LAS float*)lds;
        __syncthreads();
        if (lane < 4) red[wave * 4 + lane] = nm;
        __syncthreads();
        if (tid < 4) { float mx = red[tid]; for (int w = 1; w < 8; ++w) mx = fmaxf(mx, red[w * 4 + tid]); ((float*)(ws + WS_KNMAX))[(size_t)unit * 4 + tid] = mx; }
    }
    if (wave == 7) {
        const float* fb = a->in[I_FB] + l * 4;
        float* floc = (float*)(ws + WS_FLOC); float* ftot = (float*)(ws + WS_FTOT);
        const int r0 = t0 + 2 * lane;
        const v2u z0 = *(const v2u*)(proj + (size_t)r0 * NPROJ + C_FL), z1 = *(const v2u*)(proj + (size_t)(r0 + 1) * NPROJ + C_FL);
        const float za[4] = {bflo(z0.x), bfhi(z0.x), bflo(z0.y), bfhi(z0.y)}, zb[4] = {bflo(z1.x), bfhi(z1.x), bflo(z1.y), bfhi(z1.y)};
        v4f o0, o1, tt;
#pragma unroll
        for (int h = 0; h < 4; ++h) {
            const float xa = za[h] + fb[h], xb = zb[h] + fb[h];
            const float la = fminf(xa, 0.f) - __logf(1.0f + __expf(-fabsf(xa))), lb = fminf(xb, 0.f) - __logf(1.0f + __expf(-fabsf(xb)));
            const float tot = la + lb; float sc = tot;
#pragma unroll
            for (int o = 1; o < 64; o <<= 1) { const float v = __shfl_up(sc, o); if (lane >= o) sc += v; }
            const float ex = sc - tot;
            o0[h] = ex + la; o1[h] = ex + tot; tt[h] = sc;
        }
        *(v4f*)(floc + (size_t)r0 * 4) = o0; *(v4f*)(floc + (size_t)(r0 + 1) * 4) = o1;
        if (lane == 63) *(v4f*)(ftot + (size_t)unit * 4) = tt;
    }
}

template <int MODE> DI void attn_unit(int b, int qb, const bf16* Qb, int qpitch, const bf16* Kb, int kpitch, const bf16* VT, bf16* O, float* ssq,
                                      const float* aux, const float* aux2, const float* aux3, int auxstride, LAS unsigned char* lds, int tid, int lane, int wave) {
    constexpr int DK = (MODE == 2) ? 96 : 64, ND = DK / 16, PK = DK * 2 + 16, PCS = DK / 8;
    constexpr int KOFF = 0, KSZ = 64 * PK, VOFF = 2 * KSZ, VSZ = 64 * 136, FOFF = VOFF + 2 * VSZ, MSOFF = FOFF + 512;
    const int r32 = lane & 31, hi = lane >> 5;
    const size_t rowbase = (size_t)b * SEQ;
    const int q0 = qb * 256, qw0 = q0 + 32 * wave, q = qw0 + r32;
    LAS float* MS = (LAS float*)(lds + MSOFF);
    __syncthreads();
    if (MODE == 1) {
        if (wave == 0) {
            float v = (lane < 32) ? aux2[(size_t)lane * 4] : 0.f; const float own = v;
#pragma unroll
            for (int o = 1; o < 32; o <<= 1) { const float t = __shfl_up(v, o); if (lane >= o) v += t; }
            if (lane < 32) MS[lane] = v - own;
        }
        if (wave == 1) {
            float v = (lane < 32) ? aux3[(size_t)lane * 4] : 0.f;
#pragma unroll
            for (int o = 1; o < 32; o <<= 1) { const float t = __shfl_up(v, o); if (lane >= o) v = fmaxf(v, t); }
            if (lane < 32) MS[32 + lane] = v;
        }
    }
    if (MODE == 0) { if (tid < 320) { const int dist = 223 - tid; MS[tid] = ((unsigned)dist < 128u) ? aux[dist & 127] : NEGBIG; } }
    __syncthreads();
    v8s qr[ND];
#pragma unroll
    for (int d0 = 0; d0 < ND; ++d0) qr[d0] = *(const v8s*)(Qb + (rowbase + q) * qpitch + 16 * d0 + 8 * hi);
    const int kt_lo = (MODE == 0) ? (4 * qb - 2 > 0 ? 4 * qb - 2 : 0) : 0, kt_hi = 4 * qb + 3;
    v4u kreg0, kreg1 = {}, vreg; float freg = 0.f;
    const int krow0 = tid / PCS, kc0 = tid % PCS, krow1 = (tid + 512) / PCS, kc1 = (tid + 512) % PCS;
    const int vd = tid >> 3, vc = tid & 7;
#define ATT_LOAD(kt) do { \
        kreg0 = *(const v4u*)(Kb + (rowbase + 64 * (kt) + krow0) * kpitch + 8 * kc0); \
        if (DK == 96 && tid < 256) kreg1 = *(const v4u*)(Kb + (rowbase + 64 * (kt) + krow1) * kpitch + 8 * kc1); \
        vreg = *(const v4u*)(VT + (size_t)vd * SEQ + 64 * (kt) + 8 * vc); \
        if (MODE == 1 && tid < 64) freg = -(aux[(rowbase + 64 * (kt) + tid) * auxstride] + MS[(64 * (kt) + tid) >> 7]) * LOG2E; } while (0)
#define ATT_STORE(buf) do { \
        *(LAS v4u*)(lds + KOFF + (buf) * KSZ + krow0 * PK + 16 * kc0) = kreg0; \
        if (DK == 96 && tid < 256) *(LAS v4u*)(lds + KOFF + (buf) * KSZ + krow1 * PK + 16 * kc1) = kreg1; \
        { LAS unsigned char* vq_ = lds + VOFF + (buf) * VSZ + vd * 136 + 16 * vc; *(LAS v2u*)vq_ = (v2u){vreg.x, vreg.y}; *(LAS v2u*)(vq_ + 8) = (v2u){vreg.z, vreg.w}; } \
        if (MODE == 1 && tid < 64) ((LAS float*)(lds + FOFF + (buf) * 256))[tid] = freg; } while (0)
    constexpr bool REV = (MODE == 1);
    const int ntile = kt_hi - kt_lo + 1;
    float qn = 0.f;
    if (REV) {
#pragma unroll
        for (int d0 = 0; d0 < ND; ++d0)
#pragma unroll
            for (int j = 0; j < 8; ++j) { const float f = bf2f((unsigned short)qr[d0][j]); qn += f * f; }
        qn += __shfl_xor(qn, 32); qn = sqrtf(qn) * 1.01f;
    }
    ATT_LOAD(REV ? kt_hi : kt_lo); ATT_STORE(0);
    __syncthreads();
    float m = (MODE == 0) ? aux2[0] * LOG2E : NEGBIG;
    float lsum = (MODE == 0 && hi == 0) ? 1.f : 0.f;
    v16f o0 = {}, o1 = {};
    int buf = 0;
    bool seen = false;
    for (int it = 0; it < ntile; ++it) {
        const int kt = REV ? kt_hi - it : kt_lo + it;
        const bool more = it + 1 < ntile;
        if (more) ATT_LOAD(REV ? kt - 1 : kt + 1);
        const int k0 = 64 * kt;
        const bool active = (k0 <= qw0 + 31) && (MODE != 0 || k0 + 63 >= qw0 - 127);
        if (active) {
            const LAS unsigned char* kb = lds + KOFF + buf * KSZ + r32 * PK + 16 * hi;
            v16f p0, p1;
#pragma unroll
            for (int d0 = 0; d0 < ND; ++d0) {
                const v8s ka = *(const LAS v8s*)(kb + 32 * d0), kb2 = *(const LAS v8s*)(kb + 32 * PK + 32 * d0);
                if (d0 == 0) { p0 = MFMA32(ka, qr[0], (v16f){}); p1 = MFMA32(kb2, qr[0], (v16f){}); }
                else { p0 = MFMA32(ka, qr[d0], p0); p1 = MFMA32(kb2, qr[d0], p1); }
            }
            asm volatile("s_nop 15\n\ts_nop 7" : "+v"(p0), "+v"(p1));
            if (MODE == 1) {
                const LAS float* fb = (const LAS float*)(lds + FOFF + buf * 256);
#pragma unroll
                for (int g = 0; g < 4; ++g) {
                    const v4f f0 = *(const LAS v4f*)(fb + 8 * g + 4 * hi), f1 = *(const LAS v4f*)(fb + 32 + 8 * g + 4 * hi);
#pragma unroll
                    for (int i = 0; i < 4; ++i) { p0[4 * g + i] += f0[i]; p1[4 * g + i] += f1[i]; }
                }
            }
            if (MODE == 0) {
                const LAS float* tb = MS + (223 - q + k0 + 4 * hi);
#pragma unroll
                for (int r = 0; r < 16; ++r) { p0[r] += tb[(r & 3) + 8 * (r >> 2)]; p1[r] += tb[32 + (r & 3) + 8 * (r >> 2)]; }
            } else if (k0 + 63 > qw0) {
#pragma unroll
                for (int r = 0; r < 16; ++r) {
                    const int kv = k0 + crow(r, hi);
                    if (kv > q) p0[r] = NEGBIG;
                    if (kv + 32 > q) p1[r] = NEGBIG;
                }
            }
            float rm;
            { float ma = max3f(p0[0], p0[1], p1[0]), mb = max3f(p0[2], p0[3], p1[1]); ma = max3f(ma, p1[2], p1[3]);
#pragma unroll
              for (int r = 4; r < 16; r += 4) { ma = max3f(ma, p0[r], p0[r + 1]); mb = max3f(mb, p0[r + 2], p0[r + 3]); ma = max3f(ma, p1[r], p1[r + 1]); mb = max3f(mb, p1[r + 2], p1[r + 3]); }
              rm = max2f(ma, mb); }
            { const auto rr = __builtin_amdgcn_permlane32_swap(__float_as_uint(rm), __float_as_uint(rm), false, false); rm = max2f(__uint_as_float(rr[0]), __uint_as_float(rr[1])); }
            const float mn = max2f(m, rm), corr = __builtin_amdgcn_exp2f(m - mn);
            m = mn;
            float rs = 0.f;
#pragma unroll
            for (int r = 0; r < 16; ++r) { p0[r] = __builtin_amdgcn_exp2f(p0[r] - mn); p1[r] = __builtin_amdgcn_exp2f(p1[r] - mn); rs += p0[r] + p1[r]; }
            lsum = lsum * corr + rs;
            if (__any(corr != 1.0f)) {
#pragma unroll
                for (int r = 0; r < 16; ++r) { o0[r] *= corr; o1[r] *= corr; }
            }
            seen = true;
            const LAS unsigned char* vb = lds + VOFF + buf * VSZ + r32 * 136 + 8 * hi;
#pragma unroll
            for (int s4 = 0; s4 < 4; ++s4) {
                v4u pw;
                if (s4 == 0) { pw.x = pk2(p0[0], p0[1]); pw.y = pk2(p0[2], p0[3]); pw.z = pk2(p0[4], p0[5]); pw.w = pk2(p0[6], p0[7]); }
                if (s4 == 1) { pw.x = pk2(p0[8], p0[9]); pw.y = pk2(p0[10], p0[11]); pw.z = pk2(p0[12], p0[13]); pw.w = pk2(p0[14], p0[15]); }
                if (s4 == 2) { pw.x = pk2(p1[0], p1[1]); pw.y = pk2(p1[2], p1[3]); pw.z = pk2(p1[4], p1[5]); pw.w = pk2(p1[6], p1[7]); }
                if (s4 == 3) { pw.x = pk2(p1[8], p1[9]); pw.y = pk2(p1[10], p1[11]); pw.z = pk2(p1[12], p1[13]); pw.w = pk2(p1[14], p1[15]); }
                const v8s pf = __builtin_bit_cast(v8s, pw);
                const v2u a0 = *(const LAS v2u*)(vb + 32 * s4), a1 = *(const LAS v2u*)(vb + 32 * s4 + 16);
                const v2u c0 = *(const LAS v2u*)(vb + 32 * 136 + 32 * s4), c1 = *(const LAS v2u*)(vb + 32 * 136 + 32 * s4 + 16);
                const v4u va = {a0.x, a0.y, a1.x, a1.y}, vc2 = {c0.x, c0.y, c1.x, c1.y};
                o0 = MFMA32(__builtin_bit_cast(v8s, va), pf, o0);
                o1 = MFMA32(__builtin_bit_cast(v8s, vc2), pf, o1);
            }
        }
        if (more) ATT_STORE(buf ^ 1);
        if (REV) {
            int vote = 0;
            if (seen && kt > 0) { const float fb0 = ((const LAS float*)(lds + FOFF + buf * 256))[0]; const float kb = MS[32 + ((kt - 1) >> 1)]; vote = __all((qn * kb + fb0 - m) < -64.0f) ? 1 : 0; }
            volatile LAS int* vt = (volatile LAS int*)(MS + 64) + (it & 1) * 8;
            if (lane == 0) vt[wave] = vote;
            __syncthreads();
            const int stop = vt[0] & vt[1] & vt[2] & vt[3] & vt[4] & vt[5] & vt[6] & vt[7];
            if (stop) break;
        } else {
            __syncthreads();
        }
        buf ^= 1;
    }
#undef ATT_LOAD
#undef ATT_STORE
    lsum += __shfl_xor(lsum, 32);
    const float inv = 1.0f / lsum;
    float sq = 0.f;
#pragma unroll
    for (int r = 0; r < 16; ++r) { o0[r] *= inv; o1[r] *= inv; sq += o0[r] * o0[r] + o1[r] * o1[r]; }
    sq += __shfl_xor(sq, 32);
    if (hi == 0) ssq[(rowbase + q) * 16] = sq;
    {
        LAS unsigned char* stg = lds + 65536 + wave * 4608;
#pragma unroll
        for (int g = 0; g < 4; ++g) {
            v2u w; w.x = pk2(o0[4 * g], o0[4 * g + 1]); w.y = pk2(o0[4 * g + 2], o0[4 * g + 3]); *(LAS v2u*)(stg + r32 * 136 + (8 * g + 4 * hi) * 2) = w;
            v2u x; x.x = pk2(o1[4 * g], o1[4 * g + 1]); x.y = pk2(o1[4 * g + 2], o1[4 * g + 3]); *(LAS v2u*)(stg + r32 * 136 + (32 + 8 * g + 4 * hi) * 2) = x;
        }
        asm volatile("s_waitcnt lgkmcnt(0)" ::: "memory");
        bf16* ow = O + (rowbase + qw0) * 1024;
#pragma unroll
        for (int i = 0; i < 4; ++i) {
            const int row = i * 8 + (lane >> 3), ch = lane & 7;
            const v2u lo = *(const LAS v2u*)(stg + row * 136 + ch * 16), hi2 = *(const LAS v2u*)(stg + row * 136 + ch * 16 + 8);
            *(v4u*)(ow + (size_t)row * 1024 + ch * 8) = (v4u){lo.x, lo.y, hi2.x, hi2.y};
        }
    }
}

DI void attn_slot(AP a, int l, int v, LAS unsigned char* lds, int tid, int lane, int wave) {
    unsigned char* ws = a->ws;
    const bf16* proj = (const bf16*)(ws + WS_PROJ);
    const bf16* qm = (const bf16*)(ws + WS_QM); const bf16* km = (const bf16*)(ws + WS_KM);
    const bf16* vts = (const bf16*)(ws + WS_VTS); const bf16* vtf = (const bf16*)(ws + WS_VTF); const bf16* vtm = (const bf16*)(ws + WS_VTM);
    bf16* mix = (bf16*)(ws + WS_MIX); float* ssqg = (float*)(ws + WS_SSQG);
    const float* floc = (const float*)(ws + WS_FLOC); const float* ftot = (const float*)(ws + WS_FTOT);
    const float* btab = (const float*)(ws + WS_BTAB);
    const int bh = v >> 3, s = v & 7, b = bh >> 2, h = bh & 3;
#pragma unroll 1
    for (int i = 0; i < 2; ++i) {
        const int qb = i == 0 ? 15 - s : s;
        attn_unit<2>(b, qb, qm + 96 * h, 384, km + 96 * h, 384, vtm + (size_t)(b * 4 + h) * 64 * SEQ, mix + 768 + 64 * h, ssqg + 12 + h, nullptr, nullptr, nullptr, 0, lds, tid, lane, wave);
    }
#pragma unroll 1
    for (int i = 0; i < 2; ++i) {
        const int qb = i == 0 ? 15 - s : s;
        attn_unit<1>(b, qb, proj + C_FOXQ + 64 * h, NPROJ, proj + C_FOXK + 64 * h, NPROJ, vtf + (size_t)(b * 4 + h) * 64 * SEQ, mix + 512 + 64 * h, ssqg + 8 + h,
                     floc + h, ftot + (size_t)(b * 32) * 4 + h, (const float*)(ws + WS_KNMAX) + (size_t)(b * 32) * 4 + h, 4, lds, tid, lane, wave);
    }
#pragma unroll 1
    for (int i = 0; i < 4; ++i) {
        const int u = 4 * v + i, qb = u & 15, hq = (u >> 4) & 7, bb = u >> 7, kvh = hq >> 2;
        attn_unit<0>(bb, qb, proj + C_SWAQ + 64 * hq, NPROJ, proj + C_SWAK + 64 * kvh, NPROJ, vts + (size_t)(bb * 2 + kvh) * 64 * SEQ, mix + 64 * hq, ssqg + hq,
                     btab + hq * 128, a->in[I_SINK] + l * 8 + hq, nullptr, 0, lds, tid, lane, wave);
    }
}

DI void fixup_phase(AP a, int l, int gtid, int gthreads) {
    unsigned char* ws = a->ws;
    const float* gside = (const float*)(ws + WS_GSIDE); const float* cwp = (const float*)(ws + WS_CWP) + (size_t)l * 4 * NUP;
    bf16* A = (bf16*)(ws + WS_A);
    for (int it = gtid; it < 120 * 2 * 22 * 32; it += gthreads) {
        const int jj4 = it & 31, rest = it >> 5, pn = rest % 22, r2 = rest / 22, r = r2 & 1, tile = r2 >> 1;
        const int pm = (tile / 15) * 16 + 1 + tile % 15;
        float cv[2][4];
#pragma unroll
        for (int bj = 0; bj < 2; ++bj) {
            const int nidx = 256 * pn + 128 * bj + 4 * jj4;
            const v4f g0 = *(const v4f*)(gside + (size_t)(pm * 4 + r) * NUP + nidx);
            const v4f g1 = *(const v4f*)(gside + (size_t)(r == 1 ? pm * 4 + 0 : (pm - 1) * 4 + 3) * NUP + nidx);
            const v4f g2 = *(const v4f*)(gside + (size_t)(r == 1 ? (pm - 1) * 4 + 3 : (pm - 1) * 4 + 2) * NUP + nidx);
            const v4f w0 = *(const v4f*)(cwp + nidx), w1 = *(const v4f*)(cwp + NUP + nidx), w2 = *(const v4f*)(cwp + 2 * NUP + nidx), cb = *(const v4f*)(cwp + 3 * NUP + nidx);
#pragma unroll
            for (int i = 0; i < 4; ++i) cv[bj][i] = cb[i] + w0[i] * g2[i] + w1[i] * g1[i] + w2[i] * g0[i];
        }
        v2u w; w.x = pk2(gelu_tanh(cv[0][0]) * cv[1][0], gelu_tanh(cv[0][1]) * cv[1][1]); w.y = pk2(gelu_tanh(cv[0][2]) * cv[1][2], gelu_tanh(cv[0][3]) * cv[1][3]);
        *(v2u*)(A + (size_t)(256 * pm + r) * DFF + 128 * pn + 4 * jj4) = w;
    }
}

DI void fixup_panel(AP a, int l, int pm, int tid) {
    unsigned char* ws = a->ws;
    const float* gside = (const float*)(ws + WS_GSIDE); const float* cwp = (const float*)(ws + WS_CWP) + (size_t)l * 4 * NUP;
    for (int it = tid; it < 2 * 22 * 32; it += 512) {
        const int jj4 = it & 31, rest = it >> 5, pn = rest % 22, r = rest / 22;
        float cv[2][4];
#pragma unroll
        for (int bj = 0; bj < 2; ++bj) {
            const int nidx = 256 * pn + 128 * bj + 4 * jj4;
            const v4f g0 = *(const v4f*)(gside + (size_t)(pm * 4 + r) * NUP + nidx);
            const v4f g1 = *(const v4f*)(gside + (size_t)(r == 1 ? pm * 4 + 0 : (pm - 1) * 4 + 3) * NUP + nidx);
            const v4f g2 = *(const v4f*)(gside + (size_t)(r == 1 ? (pm - 1) * 4 + 3 : (pm - 1) * 4 + 2) * NUP + nidx);
            const v4f w0 = *(const v4f*)(cwp + nidx), w1 = *(const v4f*)(cwp + NUP + nidx), w2 = *(const v4f*)(cwp + 2 * NUP + nidx), cb = *(const v4f*)(cwp + 3 * NUP + nidx);
#pragma unroll
            for (int i = 0; i < 4; ++i) cv[bj][i] = cb[i] + w0[i] * g2[i] + w1[i] * g1[i] + w2[i] * g0[i];
        }
        v2u w; w.x = pk2(gelu_tanh(cv[0][0]) * cv[1][0], gelu_tanh(cv[0][1]) * cv[1][1]); w.y = pk2(gelu_tanh(cv[0][2]) * cv[1][2], gelu_tanh(cv[0][3]) * cv[1][3]);
        *(v2u*)(a_row(ws, 256 * pm + r) + 128 * pn + 4 * jj4) = w;
    }
}

DI void cvt_layers(AP a, LAS unsigned char* lds, int lane, int wave, int gw, int NGW, int l0, int nl) {
    unsigned char* ws = a->ws;
    LAS float* scr = (LAS float*)(lds + wave * 16384);
    constexpr int I_IN = 16 * 64, I_UQ = 4 * 12, I_UKV = 2 * 16, I_OUT = 16 * 32, I_UP = 16 * 176, I_DOWN = 44 * 32, I_LAYER = I_IN + I_UQ + I_UKV + I_OUT + I_UP + I_DOWN;
    for (int it = gw; it < nl * I_LAYER; it += NGW) {
        const int l = l0 + it / I_LAYER; int r = it % I_LAYER;
        unsigned char* wl = ws + WS_W + (size_t)l * W_LAYER;
        if (r < I_IN) { cvt_item<1>(a->in[I_WIN] + (size_t)l * 1024 * IN_COLS, 1024, IN_COLS, (bf16*)(wl + WO_IN), NPROJ, a->in[I_APRE] + l * 1024, C64, scr, r, lane); continue; } r -= I_IN;
        if (r < I_UQ) { cvt_item<0>(a->in[I_WUQ] + (size_t)l * 256 * 384, 256, 384, (bf16*)(wl + WO_UQ), 384, a->in[I_QLN] + l * 256, C96, scr, r, lane); continue; } r -= I_UQ;
        if (r < I_UKV) { cvt_item<3>(a->in[I_WUKV] + (size_t)l * 128 * 512, 128, 512, (bf16*)(wl + WO_UKV), 512, a->in[I_KVLN] + l * 128, 1.f, scr, r, lane); continue; } r -= I_UKV;
        if (r < I_OUT) { cvt_item<0>(a->in[I_WOUT] + (size_t)l * 1024 * 1024, 1024, 1024, (bf16*)(wl + WO_OUT), 1024, a->in[I_GN] + l * 1024, 1.f, scr, r, lane); continue; } r -= I_OUT;
        if (r < I_UP) { cvt_item<2>(a->in[I_WUP] + (size_t)l * 1024 * NUP, 1024, NUP, (bf16*)(wl + WO_UP), NUP, a->in[I_FPRE] + l * 1024, 1.f, scr, r, lane); continue; } r -= I_UP;
        cvt_item<0>(a->in[I_WDOWN] + (size_t)l * DFF * 1024, DFF, 1024, (bf16*)(wl + WO_DOWN), 1024, nullptr, 1.f, scr, r, lane);
    }
}

DI void prologue(AP a, LAS unsigned char* lds, int tid, int lane, int wave, int vcu, int G) {
    unsigned char* ws = a->ws;
    LAS float* scr = (LAS float*)(lds + wave * 16384);
    const int gw = vcu * 8 + wave, NGW = G * 8;
    cvt_layers(a, lds, lane, wave, gw, NGW, 0, 1);
    const int gtid = gw * 64 + lane, gth = NGW * 64;
    { float* rope = (float*)(ws + WS_ROPE);
      for (int i = gtid; i < SEQ * 16; i += gth) {
          const int pos = i >> 4, k = i & 15;
          const float inv = exp2f(-(float)k * (2.0f / 32.0f) * 13.287712379549449f);
          const float ang = (float)pos * inv;
          const float n = rintf(ang * 0.15915494309189535f);
          float rr = fmaf(-n, 6.28318548202514648f, ang); rr = fmaf(-n, -1.7484555e-7f, rr);
          rope[pos * 32 + k] = cosf(rr); rope[pos * 32 + 16 + k] = sinf(rr);
      } }
    { float* bt = (float*)(ws + WS_BTAB);
      for (int i = gtid; i < 8 * 128; i += gth) {
          const int h = i >> 7, d = i & 127; int bk = d;
          if (d >= 16) { bk = 16 + (int)(__log2f((float)d * (1.0f / 16.0f)) * (16.0f / 3.0f)); bk = bk > 31 ? 31 : bk; }
          bt[i] = a->in[I_RELB][bk * 8 + h] * LOG2E;
      } }
    { float* cwp = (float*)(ws + WS_CWP);
      for (int i = gtid; i < DEPTH * 4 * NUP; i += gth) {
          const int n = i % NUP, q = (i / NUP) & 3, l = i / (4 * NUP), sc = srccol<2>(n);
          cwp[i] = q < 3 ? a->in[I_CW][((size_t)l * 3 + q) * NUP + sc] : a->in[I_CB][(size_t)l * NUP + sc];
      } }
#pragma unroll 4
    for (int mrow = gw; mrow < T; mrow += NGW) {
        const v4f* src = (const v4f*)(a->in[I_X] + (size_t)mrow * 1024) + lane; v2u* hp = (v2u*)((bf16*)(ws + WS_HB) + (size_t)mrow * 1024) + lane;
        float s = 0.f;
#pragma unroll
        for (int j = 0; j < 4; ++j) { const v4f v = src[64 * j]; s += (v[0] * v[0] + v[1] * v[1]) + (v[2] * v[2] + v[3] * v[3]); v2u w; w.x = pk2(v[0], v[1]); w.y = pk2(v[2], v[3]); hp[64 * j] = w; }
        s = wave_sum(s);
        if (lane < 16) ((float*)(ws + WS_SLOT2))[(size_t)mrow * 16 + lane] = (lane == 0) ? s : 0.f;
    }
}

constexpr int NSP = 6, NPHASE = 1 + NSP * DEPTH;
#ifndef MK_PHM
#define MK_PHM 1023u
#endif
constexpr unsigned PHM = MK_PHM;
#ifndef MK_DUP
#define MK_DUP 0u
#endif
constexpr unsigned DUPM = MK_DUP;
__global__ void __launch_bounds__(512, 2) trunk_fwd(Args a_) {
    extern __shared__ __attribute__((aligned(16))) unsigned char lds_raw[];
    LAS unsigned char* lds = (LAS unsigned char*)lds_raw;
    cg::grid_group grid = cg::this_grid();
    const int tid0 = threadIdx.x, wave0 = __builtin_amdgcn_readfirstlane(tid0 >> 6);
    XcdBarrier bar; bar.bar = nullptr; bar.x = 0; bar.st = nullptr;
    if (a_.coop) {
        volatile LAS unsigned* misc = (volatile LAS unsigned*)(lds + MISC_OFF);
        if (tid0 < 16) misc[tid0] = 0u;
        __syncthreads();
        bar = xcd_barrier_post((unsigned*)(a_.ws + WS_CTL), misc + 8, tid0);
        if (tid0 == 0) {
            unsigned* fl = (unsigned*)(a_.ws + WS_CTL + CTL_FLAG_OFF); const unsigned g = blockIdx.x & 7u, xc = xb_xcc_id();
            atomicMax(fl + g, xc + 1u); atomicMax(fl + 8 + g, 16u - xc);
            if (gridDim.x != 256u) atomicOr(fl + 16, 1u);
        }
    }
    const int ph_lo = a_.ph_lo, ph_hi = a_.ph_hi, coop = a_.coop;
    bool fastseam = false; unsigned gepoch = 0u;
    for (int ph = ph_lo; ph < ph_hi; ++ph) {
        const int spx = ph == 0 ? 9 : (ph - 1) % NSP;
        for (int rep = 0; rep < (((DUPM >> spx) & 1u) ? 2 : 1); ++rep) {
        if (rep > 0 && coop) xcd_barrier(bar, wave0 * 64 + hw_lane());
        AP a = (AP)__builtin_amdgcn_kernarg_segment_ptr(); asm volatile("" : "+s"(a));
#define PH_TID() const int tid = wave0 * 64 + hw_lane(), lane = tid & 63, wave = wave0
        int G = gridDim.x, bx = blockIdx.x; asm volatile("" : "+s"(G), "+s"(bx));
        const int vcu = (G % 8 == 0) ? (bx % 8) * (G / 8) + bx / 8 : bx;
        unsigned char* ws = a->ws;
        if (ph == 0) {
            if (PHM & 512u) { PH_TID(); prologue(a, lds, tid, lane, wave, vcu, G); }
        } else {
            const int l = (ph - 1) / NSP, sp = (ph - 1) % NSP;
            unsigned char* wl = ws + WS_W + (size_t)l * W_LAYER;
            if (sp == 0 && (PHM & 1u)) {
                pg8::Gemm g{(const bf16*)(ws + WS_HB), (const bf16*)(wl + WO_IN), T, NPROJ, 1024}; pg8::StaticOrder S; S.init(T, NPROJ, G, bx);
                { PH_TID(); (void)lane; (void)wave; row_scales(S, (const float*)(ws + WS_SLOT2), (float*)(ws + WS_RSTDX), tid); }
                EpiProj E{(bf16*)(ws + WS_PROJ), (const float*)(ws + WS_RSTDX)};
                pg8::gemm_phase<EpiProj, pg8::StaticOrder, true, true>(lds, g, S, E, wave0 * 64 + hw_lane());
            } else if (sp == 1 && (PHM & 2u)) {
                PH_TID();
                if (l == 0) { cvt_layers(a, lds, lane, wave, vcu * 8 + wave, G * 8, 1, DEPTH - 1); __syncthreads(); }
                for (int u = vcu; u < T / 128; u += G) prep_unit(a, l, u, lds, tid, lane, wave);
            } else if (sp == 2 && (PHM & 4u)) {
                PH_TID(); for (int v = vcu; v < 256; v += G) attn_slot(a, l, v, lds, tid, lane, wave);
            } else if (sp == 3 && (PHM & 8u)) {
                pg8::Gemm g{(const bf16*)(ws + WS_MIX), (const bf16*)(wl + WO_OUT), T, 1024, 1024}; pg8::StaticOrder S; S.init(T, 1024, G, bx);
                pg8::Unit u0{-1, -1}, u1{-1, -1};
                { PH_TID(); (void)lane; (void)wave; const float* sg = (const float*)(ws + WS_SSQG);
                  if (S.next(0, u0)) seam_factors(sg, u0.pm, (LAS float*)(lds + HALO_OFF), tid);
                  if (S.next(1, u1)) seam_factors(sg, u1.pm, (LAS float*)(lds + HALO_OFF) + 768, tid);
                  __syncthreads(); }
                EpiRes<true> E{a, l, lds + HALO_OFF, u0.pm, u0.pn};
                pg8::gemm_phase<EpiRes<true>, pg8::StaticOrder, true, true>(lds, g, S, E, wave0 * 64 + hw_lane());
            } else if (sp == 4 && (PHM & 32u)) {
                pg8::Gemm g{(const bf16*)(ws + WS_HB), (const bf16*)(wl + WO_UP), T, NUP, 1024}; pg8::StaticOrder S; S.init(T, NUP, G, bx);
                { PH_TID(); (void)lane; (void)wave; row_scales(S, (const float*)(ws + WS_SLOT2), (float*)(ws + WS_RSTDX), tid); }
                EpiConv E{ws, (const float*)(ws + WS_CWP) + (size_t)l * 4 * NUP, (float*)(ws + WS_GSIDE), lds + HALO_OFF, (const float*)(ws + WS_RSTDX)};
                pg8::gemm_phase<EpiConv, pg8::StaticOrder, true, true>(lds, g, S, E, wave0 * 64 + hw_lane());
            } else if (sp == 5 && (PHM & 128u)) {
                pg8::Gemm g{(const bf16*)(ws + WS_PROJ), (const bf16*)(wl + WO_DOWN), T, 1024, DFF, (const char*)(ws + WS_MIX)}; pg8::StaticOrder S; S.init(T, 1024, G, bx);
                { PH_TID(); (void)lane; (void)wave; pg8::Unit u;
                  for (int i = 0; S.next(i, u); ++i) if ((u.pm & 15) != 0) fixup_panel(a, l, u.pm, tid);
                  asm volatile("s_waitcnt vmcnt(0)" ::: "memory"); __syncthreads(); }
                EpiRes<false> E{a, l, lds + HALO_OFF, 0, 0};
                pg8::gemm_phase<EpiRes<false>, pg8::StaticOrder, true, true>(lds, g, S, E, wave0 * 64 + hw_lane());
            }
        }
        }
        if (ph + 1 < ph_hi && coop && ph == 0) { grid.sync(); { const unsigned* fl = (const unsigned*)(a_.ws + WS_CTL + CTL_FLAG_OFF); bool ok = __hip_atomic_load(fl + 16, __ATOMIC_RELAXED, __HIP_MEMORY_SCOPE_AGENT) == 0u;
            for (int g = 0; g < 8; ++g) { const unsigned mx = __hip_atomic_load(fl + g, __ATOMIC_RELAXED, __HIP_MEMORY_SCOPE_AGENT), mi = __hip_atomic_load(fl + 8 + g, __ATOMIC_RELAXED, __HIP_MEMORY_SCOPE_AGENT); ok = ok && (mx + mi == 17u); }
            fastseam = ok; } }
        else if (ph + 1 < ph_hi && coop && fastseam && ph != 2) {        xcd_local_barrier((unsigned*)(a_.ws + WS_CTL + CTL_GRP_OFF) + 64 * (blockIdx.x & 7u), gepoch, wave0 * 64 + hw_lane()); ++gepoch; }
        else if (ph + 1 < ph_hi) { if (coop) { if (ph == 0) grid.sync(); else xcd_barrier(bar, wave0 * 64 + hw_lane()); if (DUPM & 1024u) xcd_barrier(bar, wave0 * 64 + hw_lane()); } }
    }
}

#ifndef MK_COOP
#define MK_COOP 0
#endif
extern "C" void kernel_launch(void* const* d_in, const int* in_sizes, int n_in, void* d_out, int out_size, void* d_ws, size_t ws_size, hipStream_t stream) {
    static int grid = 0;
    if (grid == 0) {
        if (n_in != 19 || out_size != T * 1024 || ws_size < WS_END) { fprintf(stderr, "kernel_launch: unexpected shapes (n_in %d out %d ws %zu)\n", n_in, out_size, ws_size); grid = -1; return; }
        int dev = 0, cus = 0, per_cu = 0;
        hipGetDevice(&dev); hipDeviceGetAttribute(&cus, hipDeviceAttributeMultiprocessorCount, dev);
        hipFuncSetAttribute((const void*)trunk_fwd, hipFuncAttributeMaxDynamicSharedMemorySize, LDS_BYTES);
        hipOccupancyMaxActiveBlocksPerMultiprocessor(&per_cu, (const void*)trunk_fwd, 512, LDS_BYTES);
        if (per_cu < 1) { fprintf(stderr, "kernel_launch: occupancy query says %d blocks/CU\n", per_cu); per_cu = 1; }
        (void)hipGetLastError();
        grid = cus * per_cu;
        fprintf(stderr, "kernel_launch: grid %d (cus %d x %d)\n", grid, cus, per_cu);
    }
    if (grid < 0) return;
    Args a{};
    for (int i = 0; i < 19; ++i) a.in[i] = (const float*)d_in[i];
    a.out = (float*)d_out; a.ws = (unsigned char*)d_ws; a.pad = 0;
#if MK_COOP
    if (hipMemsetAsync((char*)d_ws + WS_CTL, 0, CTL_BYTES, stream) != hipSuccess) { fprintf(stderr, "kernel_launch: memset of barrier words failed\n"); return; }
    a.ph_lo = 0; a.ph_hi = NPHASE; a.coop = 1;
    void* args[] = {&a};
    hipError_t e = hipLaunchCooperativeKernel((const void*)trunk_fwd, dim3(grid), dim3(512), args, LDS_BYTES, stream);
    if (e != hipSuccess) fprintf(stderr, "cooperative launch failed: %s (grid %d)\n", hipGetErrorString(e), grid);
#else
    a.coop = 0;
    for (int ph = 0; ph < NPHASE; ++ph) {
        a.ph_lo = ph; a.ph_hi = ph + 1;
        hipLaunchKernelGGL(trunk_fwd, dim3(grid), dim3(512), LDS_BYTES, stream, a);
    }
#endif
}
```

```cpp
#include <hip/hip_runtime.h>
#include <hip/hip_cooperative_groups.h>
#include <cstdio>
#include <cstdint>
namespace cg = cooperative_groups;
#define MK_COOP 1
namespace pg8 {
#define PG8_LAS __attribute__((address_space(3)))
typedef unsigned short bf16_t;
typedef short bf16x8 __attribute__((ext_vector_type(8)));
typedef float f32x4 __attribute__((ext_vector_type(4)));
typedef unsigned u32x4 __attribute__((ext_vector_type(4)));
constexpr int BM = 256, BK = 64, HALF = 128, HTB = HALF * BK * 2  , STAGE_BYTES = 8 * HTB, NXCD = 8, WGM = 8;

__host__ __device__ __forceinline__ int lds_byte(int r, int c) { const int st = (r >> 4) * 2 + (c >> 5), rr = r & 15, cc = c & 31, ob = rr * 64 + cc * 2; return st * 1024 + (ob ^ (((ob >> 9) & 1) << 5)); }
__host__ __device__ __forceinline__ void stage_rc(int b, int& R, int& C) { const int st = b / 1024, sb = b % 1024, swz = sb ^ (((sb >> 9) & 1) << 5); R = (st >> 1) * 16 + swz / 64; C = (st & 1) * 32 + (swz % 64) / 2; }
__host__ __device__ __forceinline__ int perm32(int rho) { const int n = rho >> 4, i = rho & 15; return 8 * (i >> 2) + 4 * n + (i & 3); }

struct Unit { int pm, pn; };
struct Gemm { const bf16_t* A; const bf16_t* Bt; int M, N, K; const char* Asplit = nullptr;
    __device__ __forceinline__ const char* apanel(int pm, size_t tstep) const {
        if (!Asplit) return (const char*)A + (size_t)pm * tstep;
        const int gb = pm >> 4, j = pm & 15;
        return j < 11 ? (const char*)A + ((size_t)gb << 24) + (size_t)j * tstep : Asplit + ((size_t)gb << 23) + (size_t)(j - 11) * tstep;
    } };

struct StaticOrder {
    int nM, nN, nwg, G, c;
    __host__ __device__ void init(int M, int N, int G_, int c_) { nM = M / BM; nN = N / BM; nwg = nM * nN; G = G_; c = c_; }
    __host__ __device__ bool next(int i, Unit& u) const {
        const long L = (long)i * G + c; if (L >= nwg) return false;
        int wgid = (int)L; { const int q = nwg / NXCD, r = nwg % NXCD, xcd = wgid % NXCD, off = wgid / NXCD; wgid = (xcd < r ? xcd * (q + 1) : r * (q + 1) + (xcd - r) * q) + off; }
        const int nig = WGM * nN, gid = wgid / nig, fm = gid * WGM, gsz = (nM - fm) < WGM ? (nM - fm) : WGM;
        u.pm = fm + ((wgid % nig) % gsz); u.pn = (wgid % nig) / gsz; return true;
    }
    __device__ __forceinline__ void a_ready(const Unit&) const {}
    __device__ __forceinline__ void done(const Unit&) const {}
};

__device__ __forceinline__ unsigned cvt_pk_bf16(float lo, float hi) { unsigned r; asm volatile("v_cvt_pk_bf16_f32 %0, %1, %2" : "=v"(r) : "v"(lo), "v"(hi)); return r; }
typedef float f32x2 __attribute__((ext_vector_type(2)));
__device__ __forceinline__ f32x2 gelu_pk(f32x2 v) {
    const f32x2 av = __builtin_elementwise_abs(v), d = av * 0.2316418882f + 1.0f;
    f32x2 t; t.x = __builtin_amdgcn_rcpf(d.x); t.y = __builtin_amdgcn_rcpf(d.y);
    f32x2 q = t * 0.5307027145f + (-0.7265760135f); q = q * t + 0.7107068705f; q = q * t + (-0.142248368f); q = q * t + 0.127414796f; q = q * t;
    const f32x2 s = (v * v) * (-0.72134752044f);
    f32x2 e; e.x = __builtin_amdgcn_exp2f(s.x); e.y = __builtin_amdgcn_exp2f(s.y);
    const f32x2 m = v * (q * e), r = v - m;
    f32x2 o; o.x = v.x < 0.f ? m.x : r.x; o.y = v.y < 0.f ? m.y : r.y; return o;
}

template <int ACT  > struct EpiBf16 {
    static constexpr bool PERM = true, AFTER_DRAIN = false, KSEG = false; static_assert(ACT == 0 || ACT == 1, "EpiBf16: ACT is 0 (none) or 1 (gelu_pk)");
    bf16_t* O; int ldc; const float* bias; int split_cols; size_t split_stride; float scale0;
    __device__ __forceinline__ void operator()(const f32x4 (&acc)[2][2][4][2], const Unit& u, int wr, int wc, int fr, int fq) const {
        const int row0 = u.pm * BM + wr * 64 + fr; int colt = u.pn * BM; bf16_t* base = O;
        float sc = 1.f; if (split_cols) { const int t = colt / split_cols; base += (size_t)t * split_stride; colt -= t * split_cols; if (t == 0) sc = scale0; }
        const int col0 = colt + wc * 32 + 8 * fq, bcol0 = u.pn * BM + wc * 32 + 8 * fq;
        f32x4 bv[2][2];
#pragma unroll
        for (int bj = 0; bj < 2; ++bj)
#pragma unroll
            for (int n = 0; n < 2; ++n) bv[bj][n] = bias ? *(const f32x4*)(bias + bcol0 + bj * HALF + 4 * n) : (f32x4){0.f, 0.f, 0.f, 0.f};
#pragma unroll
        for (int ai = 0; ai < 2; ++ai)
#pragma unroll
            for (int m = 0; m < 4; ++m) { bf16_t* rowp = base + (size_t)(row0 + ai * HALF + m * 16) * ldc + col0;
#pragma unroll
                for (int bj = 0; bj < 2; ++bj) { f32x4 v0 = acc[ai][bj][m][0] + bv[bj][0], v1 = acc[ai][bj][m][1] + bv[bj][1];
                    if (ACT == 1) { f32x2 a = gelu_pk((f32x2){v0[0], v0[1]}), b = gelu_pk((f32x2){v0[2], v0[3]}), c = gelu_pk((f32x2){v1[0], v1[1]}), d = gelu_pk((f32x2){v1[2], v1[3]});
                        v0 = (f32x4){a.x, a.y, b.x, b.y}; v1 = (f32x4){c.x, c.y, d.x, d.y}; }
                    v0 = v0 * sc; v1 = v1 * sc; u32x4 w; w.x = cvt_pk_bf16(v0[0], v0[1]); w.y = cvt_pk_bf16(v0[2], v0[3]); w.z = cvt_pk_bf16(v1[0], v1[1]); w.w = cvt_pk_bf16(v1[2], v1[3]);
                    *(u32x4*)(rowp + bj * HALF) = w; } }
    }
};
template <class Epi, class Sched, bool ALIGN_EPI = false, bool SP2 = false>
__device__ __forceinline__ void gemm_phase(PG8_LAS unsigned char* lds, const Gemm g, const Sched& S, const Epi& E, int tid_in) {
    int tid_ = tid_in; asm volatile("" : "+v"(tid_));
    const int tid = tid_, wid = __builtin_amdgcn_readfirstlane(tid >> 6), lane = tid & 63, wr = wid >> 2, wc = wid & 3, fr = lane & 15, fq = lane >> 4;
    const int K = g.K, nt = K / BK;
    unsigned voffA[2], voffB[2];
#pragma unroll
    for (int i = 0; i < 2; ++i) { int R, C; stage_rc(tid * 16 + i * 8192, R, C); const int Rb = Epi::PERM ? ((R & ~31) + perm32(R & 31)) : R;
        voffA[i] = (unsigned)(R * K + C) * 2u; voffB[i] = (unsigned)(Rb * K + C) * 2u; }
    const size_t kstep = (size_t)(BK * 2);
    const size_t hstep = (size_t)HALF * K * 2;
    const size_t tstep = 2 * hstep;
    const unsigned ldsw = (unsigned)wid * 1024u;
    const int aoff = lds_byte(wr * 64 + fr, fq * 8), boff = lds_byte(wc * 32 + fr, fq * 8);
#define PG8_SA(b, h) (((b) * 2 + (h)) * HTB)
#define PG8_SB(b, h) ((4 + (b) * 2 + (h)) * HTB)
#define PG8_STAGE(bufoff, gbase, voff) do { _Pragma("unroll") for (int _i = 0; _i < 2; ++_i) \
        __builtin_amdgcn_global_load_lds((const unsigned*)((const char*)(gbase) + (voff)[_i]), (PG8_LAS unsigned*)(lds + (bufoff) + ldsw + _i * 8192), 16, 0, 0); } while (0)
#define PG8_LDA(dst, b, h) do { _Pragma("unroll") for (int m = 0; m < 4; ++m) _Pragma("unroll") for (int k = 0; k < 2; ++k) dst[m][k] = *(const PG8_LAS bf16x8*)(lds + PG8_SA(b, h) + aoff + m * 2048 + k * 1024); } while (0)
#define PG8_LDB(dst, b, h) do { _Pragma("unroll") for (int n = 0; n < 2; ++n) _Pragma("unroll") for (int k = 0; k < 2; ++k) dst[n][k] = *(const PG8_LAS bf16x8*)(lds + PG8_SB(b, h) + boff + n * 2048 + k * 1024); } while (0)
#define PG8_MMA(ai, bj, At, Bt) do { __builtin_amdgcn_s_setprio(1); _Pragma("unroll") for (int m = 0; m < 4; ++m) _Pragma("unroll") for (int n = 0; n < 2; ++n) _Pragma("unroll") for (int k = 0; k < 2; ++k) \
        acc[ai][bj][m][n] = __builtin_amdgcn_mfma_f32_16x16x32_bf16(Bt[n][k], At[m][k], acc[ai][bj][m][n], 0, 0, 0); __builtin_amdgcn_s_setprio(0); } while (0)
#define PG8_WAIT_V(n) asm volatile("s_waitcnt vmcnt(" #n ")" ::: "memory")
#define PG8_WAIT_L(n) asm volatile("s_waitcnt lgkmcnt(" #n ")" ::: "memory")
#define PG8_BAR __builtin_amdgcn_s_barrier()
#define PG8_SCHED __builtin_amdgcn_sched_barrier(0)
    Unit cur, nxt; int ui = 0;
    if (!S.next(0, cur)) return;
    f32x4 acc[2][2][4][2];
#pragma unroll
    for (int a = 0; a < 2; ++a)
#pragma unroll
        for (int b = 0; b < 2; ++b)
#pragma unroll
            for (int m = 0; m < 4; ++m)
#pragma unroll
                for (int n = 0; n < 2; ++n) acc[a][b][m][n] = (f32x4){0.f, 0.f, 0.f, 0.f};
    bf16x8 At[4][2], B0[2][2], B1[2][2];
    const char* cA = g.apanel(cur.pm, tstep); const char* cB = (const char*)g.Bt + (size_t)cur.pn * tstep;
    S.a_ready(cur);
    if constexpr (SP2) {
        PG8_STAGE(PG8_SB(0, 0), cB, voffB); PG8_STAGE(PG8_SB(0, 1), cB + hstep, voffB); PG8_STAGE(PG8_SA(0, 0), cA, voffA); PG8_STAGE(PG8_SA(0, 1), cA + hstep, voffA);
        if (wr == 1) PG8_BAR;
        PG8_WAIT_V(2); PG8_BAR;
        PG8_STAGE(PG8_SB(1, 0), cB + kstep, voffB); PG8_STAGE(PG8_SA(1, 0), cA + kstep, voffA); PG8_STAGE(PG8_SB(1, 1), cB + hstep + kstep, voffB);
        PG8_WAIT_V(6); PG8_BAR;
    } else {
        PG8_STAGE(PG8_SB(0, 0), cB, voffB); PG8_STAGE(PG8_SA(0, 0), cA, voffA); PG8_STAGE(PG8_SB(0, 1), cB + hstep, voffB); PG8_STAGE(PG8_SA(0, 1), cA + hstep, voffA);
        if (wr == 1) PG8_BAR;
        PG8_WAIT_V(4); PG8_BAR;
        PG8_STAGE(PG8_SB(1, 0), cB + kstep, voffB); PG8_STAGE(PG8_SA(1, 0), cA + kstep, voffA); PG8_STAGE(PG8_SB(1, 1), cB + hstep + kstep, voffB);
        PG8_WAIT_V(6); PG8_BAR;
    }
    for (;;) {
        const bool has_next = S.next(ui + 1, nxt);
        const char* nA = has_next ? g.apanel(nxt.pm, tstep) : cA; const char* nB = has_next ? (const char*)g.Bt + (size_t)nxt.pn * tstep : cB;
        for (int seg = 0; seg < (Epi::KSEG ? 3 : 1); ++seg) {
        if constexpr (Epi::KSEG) { if (seg > 0) E.kscale(acc, seg, cur, wr, fr); }
        const int tb_ = Epi::KSEG ? (seg == 0 ? 0 : (seg == 1 ? 8 : 12)) : 0, te_ = Epi::KSEG ? (seg == 0 ? 8 : (seg == 1 ? 12 : nt)) : nt;
#pragma unroll 1
        for (int t = tb_; t < te_; t += 2) {
            const bool last = (t == nt - 2);
            const char* a1 = cA + (size_t)(t + 1) * kstep;
            const char* a2 = last ? nA : cA + (size_t)(t + 2) * kstep; const char* b2 = last ? nB : cB + (size_t)(t + 2) * kstep;
            const char* a3 = a2 + kstep; const char* b3 = b2 + kstep;
            if (last && has_next) S.a_ready(nxt);
            if constexpr (SP2) {
            PG8_LDB(B0, 0, 0); PG8_LDB(B1, 0, 1); PG8_SCHED; PG8_LDA(At, 0, 0); PG8_STAGE(PG8_SA(1, 1), a1 + hstep, voffA);
            PG8_WAIT_V(8); PG8_WAIT_L(0); PG8_BAR; PG8_MMA(0, 0, At, B0); PG8_MMA(0, 1, At, B1); PG8_BAR; PG8_SCHED;
            PG8_LDA(At, 0, 1); PG8_STAGE(PG8_SB(0, 0), b2, voffB); PG8_STAGE(PG8_SB(0, 1), b2 + hstep, voffB); PG8_STAGE(PG8_SA(0, 0), a2, voffA);
            PG8_WAIT_V(8); PG8_WAIT_L(0); PG8_BAR; PG8_MMA(1, 0, At, B0); PG8_MMA(1, 1, At, B1); PG8_BAR; PG8_SCHED;
            PG8_LDB(B0, 1, 0); PG8_LDB(B1, 1, 1); PG8_SCHED; PG8_LDA(At, 1, 0); PG8_STAGE(PG8_SA(0, 1), a2 + hstep, voffA);
            PG8_WAIT_V(8); PG8_WAIT_L(0); PG8_BAR; PG8_MMA(0, 0, At, B0); PG8_MMA(0, 1, At, B1); PG8_BAR; PG8_SCHED;
            PG8_LDA(At, 1, 1); PG8_STAGE(PG8_SB(1, 0), b3, voffB); PG8_STAGE(PG8_SB(1, 1), b3 + hstep, voffB); PG8_STAGE(PG8_SA(1, 0), a3, voffA);
            PG8_WAIT_V(8); PG8_WAIT_L(0); PG8_BAR; PG8_MMA(1, 0, At, B0); PG8_MMA(1, 1, At, B1); PG8_BAR; PG8_SCHED;
            } else {
            PG8_LDB(B0, 0, 0); PG8_SCHED; PG8_LDA(At, 0, 0); PG8_STAGE(PG8_SA(1, 1), a1 + hstep, voffA);
            PG8_WAIT_L(8); PG8_BAR; PG8_WAIT_L(0); PG8_MMA(0, 0, At, B0); PG8_BAR; PG8_SCHED;
            PG8_LDB(B1, 0, 1); PG8_STAGE(PG8_SB(0, 0), b2, voffB);
            PG8_BAR; PG8_WAIT_L(0); PG8_MMA(0, 1, At, B1); PG8_BAR;
            PG8_LDA(At, 0, 1); PG8_STAGE(PG8_SA(0, 0), a2, voffA);
            PG8_BAR; PG8_WAIT_L(0); PG8_MMA(1, 0, At, B0); PG8_BAR; PG8_SCHED;
            PG8_STAGE(PG8_SB(0, 1), b2 + hstep, voffB);
            PG8_WAIT_V(6); PG8_BAR; PG8_MMA(1, 1, At, B1); PG8_BAR;
            PG8_LDB(B0, 1, 0); PG8_SCHED; PG8_LDA(At, 1, 0); PG8_STAGE(PG8_SA(0, 1), a2 + hstep, voffA);
            PG8_WAIT_L(8); PG8_BAR; PG8_WAIT_L(0); PG8_MMA(0, 0, At, B0); PG8_BAR; PG8_SCHED;
            PG8_LDB(B1, 1, 1); PG8_STAGE(PG8_SB(1, 0), b3, voffB);
            PG8_BAR; PG8_WAIT_L(0); PG8_MMA(0, 1, At, B1); PG8_BAR;
            PG8_LDA(At, 1, 1); PG8_STAGE(PG8_SA(1, 0), a3, voffA);
            PG8_BAR; PG8_WAIT_L(0); PG8_MMA(1, 0, At, B0); PG8_BAR; PG8_SCHED;
            PG8_STAGE(PG8_SB(1, 1), b3 + hstep, voffB);
            PG8_WAIT_V(6); PG8_BAR; PG8_MMA(1, 1, At, B1); PG8_BAR;
            }
        }
        }
        if constexpr (ALIGN_EPI) { if (wr == 0) PG8_BAR; }
        if constexpr (!Epi::AFTER_DRAIN) { E(acc, cur, wr, wc, fr, fq); S.done(cur); }
        if (!has_next) break;
#pragma unroll
        for (int a = 0; a < 2; ++a)
#pragma unroll
            for (int b = 0; b < 2; ++b)
#pragma unroll
                for (int m = 0; m < 4; ++m)
#pragma unroll
                    for (int n = 0; n < 2; ++n) acc[a][b][m][n] = (f32x4){0.f, 0.f, 0.f, 0.f};
        cur = nxt; cA = nA; cB = nB; ++ui;
        if constexpr (ALIGN_EPI) { if (wr == 1) PG8_BAR; }
    }
    PG8_WAIT_V(0);
    if constexpr (!ALIGN_EPI) { if (wr == 0) PG8_BAR; }
    PG8_BAR;
    if constexpr (Epi::AFTER_DRAIN) { E.fused(acc, cur, wr, wc, fr, fq, lds, wid, lane); S.done(cur); }
#undef PG8_SA
#undef PG8_SB
#undef PG8_STAGE
#undef PG8_LDA
#undef PG8_LDB
#undef PG8_MMA
#undef PG8_WAIT_V
#undef PG8_WAIT_L
#undef PG8_BAR
#undef PG8_SCHED
}
}

#define DI __device__ __forceinline__
#define LAS __attribute__((address_space(3)))
typedef unsigned short bf16;
typedef short v8s __attribute__((ext_vector_type(8)));
typedef float v4f __attribute__((ext_vector_type(4)));
typedef float v16f __attribute__((ext_vector_type(16)));
typedef unsigned v4u __attribute__((ext_vector_type(4)));
typedef unsigned v2u __attribute__((ext_vector_type(2)));
typedef float f32x2_t __attribute__((ext_vector_type(2)));
typedef __bf16 bf16x2_t __attribute__((ext_vector_type(2)));

constexpr int BATCH = 8, SEQ = 4096, DMODEL = 1024, DEPTH = 4, T = BATCH * SEQ;
constexpr int NPROJ = 2048;
constexpr int C_SWAQ = 0, C_SWAK = 512, C_SWAV = 640, C_FOXQ = 768, C_FOXK = 1024, C_FOXV = 1280, C_CQ = 1536, C_CKV = 1792, C_KR = 1920, C_FL = 1952;
constexpr int DFF = 2816, NUP = 5632, IN_COLS = 1956;
constexpr float LOG2E = 1.4426950408889634f;
constexpr float C64 = 0.125f * LOG2E;
constexpr float C96 = 0.10206207261596575f * LOG2E;
constexpr float EPS = 1e-6f;
constexpr float NEGBIG = -1e30f;

constexpr size_t MiB = 1u << 20;
constexpr size_t WS_ROPE = 0, WS_BTAB = MiB / 2, WS_CWP = 1 * MiB, WS_RSTDX = MiB + MiB / 2, WS_SSQY = 16 * MiB, WS_SSQG = 18 * MiB, WS_FLOC = 3 * MiB, WS_FTOT = 3 * MiB + MiB / 2, WS_KNMAX = 3 * MiB + MiB / 2 + 65536, WS_GSIDE = 4 * MiB;
constexpr size_t WS_W = 20 * MiB, W_LAYER = 23 * MiB, WO_IN = 0, WO_OUT = 4 * MiB, WO_UP = 6 * MiB, WO_DOWN = 17 * MiB, WO_UQ = 22 * MiB + MiB / 2, WO_UKV = 22 * MiB + 3 * (MiB / 4);
constexpr size_t WS_HB = 112 * MiB, WS_R1 = 176 * MiB;
constexpr size_t WS_PROJ = WS_R1, WS_QM = WS_R1 + 128 * MiB, WS_KM = WS_R1 + 152 * MiB, WS_VTS = WS_R1 + 176 * MiB, WS_VTF = WS_R1 + 184 * MiB, WS_VTM = WS_R1 + 200 * MiB;
constexpr size_t WS_A = WS_R1, WS_Y1 = WS_R1;
constexpr size_t WS_MIX = 392 * MiB, WS_Y2 = WS_MIX, WS_CTL = 456 * MiB, CTL_BYTES = 16384 + 4 * 2 * 2 * 128 * 256 + 4096, CTL_CNT_OFF = 16384, CTL_GRP_OFF = 16384 + 4 * 2 * 2 * 128 * 256, CTL_FLAG_OFF = 15872, WS_SLOT2 = 457 * MiB, WS_END = 459 * MiB;

constexpr int RING_BYTES = 131072, HALO_OFF = RING_BYTES + 1024, LDS_BYTES = 147456, MISC_OFF = LDS_BYTES - 256;

DI unsigned pk2(float lo, float hi) { f32x2_t v = {lo, hi}; bf16x2_t b = __builtin_convertvector(v, bf16x2_t); return __builtin_bit_cast(unsigned, b); }
DI float bf2f(unsigned short u) { return __uint_as_float((unsigned)u << 16); }
DI float bflo(unsigned u) { return __uint_as_float(u << 16); }
DI float bfhi(unsigned u) { return __uint_as_float(u & 0xffff0000u); }
DI float max3f(float a, float b, float c) { float r; asm("v_max3_f32 %0, %1, %2, %3" : "=v"(r) : "v"(a), "v"(b), "v"(c)); return r; }
DI float max2f(float a, float b) { float r; asm("v_max_f32_e32 %0, %1, %2" : "=v"(r) : "v"(a), "v"(b)); return r; }
DI float fma_s(float a, float b, float c) { float r; asm("v_fma_f32 %0, %1, %2, %3" : "=v"(r) : "v"(a), "v"(b), "v"(c)); return r; }
DI int crow(int r, int hi) { return (r & 3) + 8 * (r >> 2) + 4 * hi; }
DI int hw_lane() { int l; asm volatile("v_mbcnt_lo_u32_b32 %0, -1, 0\n\tv_mbcnt_hi_u32_b32 %0, -1, %0" : "=v"(l)); return l; }
DI float wave_sum(float v) {
#pragma unroll
    for (int o = 1; o < 64; o <<= 1) v += __shfl_xor(v, o);
    return v;
}
DI float gelu_tanh(float x) {
    constexpr float C1 = -2.0f * 0.7978845608028654f * LOG2E, C2 = C1 * 0.044715f;
    const float e = __builtin_amdgcn_exp2f(x * __builtin_fmaf(x * x, C2, C1));
    return x * __builtin_amdgcn_rcpf(1.0f + e);
}
template <int CTRL> DI float dppf(float v) { return __int_as_float(__builtin_amdgcn_mov_dpp(__float_as_int(v), CTRL, 0xf, 0xf, true)); }

__device__ __forceinline__ void xcd_local_barrier(unsigned* ctr, unsigned epoch, int xtid) {
    asm volatile("s_waitcnt vmcnt(0)" ::: "memory");
    __syncthreads();
    if (xtid == 0) {
        __builtin_amdgcn_s_waitcnt(0);
        const unsigned target = (epoch + 1u) * 32u;
        (void)__hip_atomic_fetch_add(ctr, 1u, __ATOMIC_RELAXED, __HIP_MEMORY_SCOPE_AGENT);
        unsigned sp = 0u;
        while (__hip_atomic_load(ctr, __ATOMIC_RELAXED, __HIP_MEMORY_SCOPE_AGENT) < target) { __builtin_amdgcn_s_sleep(1); if (++sp > (1u << 22)) break; }
        __builtin_amdgcn_fence(__ATOMIC_ACQUIRE, "agent");
        asm volatile("s_waitcnt vmcnt(0)" ::: "memory");
    }
    __syncthreads();
}

struct Args { const float* in[19]; float* out; unsigned char* ws; int ph_lo, ph_hi, coop, pad; };
typedef const __attribute__((address_space(4))) Args* AP;
enum { I_X = 0, I_APRE, I_WIN, I_FB, I_SINK, I_RELB, I_QLN, I_WUQ, I_KVLN, I_WUKV, I_GN, I_WOUT, I_APOST, I_FPRE, I_WUP, I_CW, I_CB, I_WDOWN, I_FPOST };


template <bool KSEG_> struct EpiY {
    static constexpr bool PERM = true, AFTER_DRAIN = false, KSEG = KSEG_;
    bf16* Y; float* ssq; const float* ssqg; LAS unsigned char* fsl;
    DI void kprep(const pg8::Unit& u, int wid, int wr, int fr, int fq) const {
        LAS float* F = (LAS float*)fsl + wid * 384;
#pragma unroll
        for (int j = 0; j < 2; ++j) {
            const int idx = 2 * fq + j, ai = idx >> 2, m = idx & 3;
            const int row = u.pm * 256 + ai * 128 + wr * 64 + m * 16 + fr;
            const v4f s0 = *(const v4f*)(ssqg + (size_t)row * 16), s1 = *(const v4f*)(ssqg + (size_t)row * 16 + 4), s2 = *(const v4f*)(ssqg + (size_t)row * 16 + 8), s3 = *(const v4f*)(ssqg + (size_t)row * 16 + 12);
            const float qa = ((s0[0] + s0[1]) + (s0[2] + s0[3])) + ((s1[0] + s1[1]) + (s1[2] + s1[3])), qb = (s2[0] + s2[1]) + (s2[2] + s2[3]), qc = (s3[0] + s3[1]) + (s3[2] + s3[3]);
            const float vb = qb * (1.0f / 256.0f) + EPS, vc = qc * (1.0f / 256.0f) + EPS;
            const float ra = rsqrtf(qa * (1.0f / 512.0f) + EPS), rb = rsqrtf(vb), rc = rsqrtf(vc);
            const int r = ai * 64 + m * 16 + fr;
            F[r] = ra * (vb * rb); F[128 + r] = rb * (vc * rc); F[256 + r] = rc;
            asm volatile("" ::: "memory");
        }
    }
    DI void kscale(pg8::f32x4 (&acc)[2][2][4][2], int seg, int wid, int fr) const {
        const LAS float* F = (const LAS float*)fsl + wid * 384 + ((seg == 1) ? 0 : 128);
#pragma unroll
        for (int ai = 0; ai < 2; ++ai)
#pragma unroll
            for (int m = 0; m < 4; ++m) {
                const float f = F[ai * 64 + m * 16 + fr];
#pragma unroll
                for (int bj = 0; bj < 2; ++bj)
#pragma unroll
                    for (int n = 0; n < 2; ++n) acc[ai][bj][m][n] = acc[ai][bj][m][n] * f;
            }
    }
    DI void operator()(const pg8::f32x4 (&acc)[2][2][4][2], const pg8::Unit& u, int wr, int wc, int fr, int fq) const {
        const LAS float* F = (const LAS float*)fsl + (wr * 4 + wc) * 384 + 256;
#pragma unroll
        for (int ai = 0; ai < 2; ++ai)
#pragma unroll
            for (int m = 0; m < 4; ++m) {
                const int row = u.pm * 256 + ai * 128 + wr * 64 + m * 16 + fr;
                float sc = 1.f; if (KSEG) sc = F[ai * 64 + m * 16 + fr];
                float q = 0.f;
#pragma unroll
                for (int bj = 0; bj < 2; ++bj) {
                    const pg8::f32x4 v0 = acc[ai][bj][m][0] * sc, v1 = acc[ai][bj][m][1] * sc;
                    q += (v0[0] * v0[0] + v0[1] * v0[1]) + (v0[2] * v0[2] + v0[3] * v0[3]) + (v1[0] * v1[0] + v1[1] * v1[1]) + (v1[2] * v1[2] + v1[3] * v1[3]);
                    v4u w; w.x = pk2(v0[0], v0[1]); w.y = pk2(v0[2], v0[3]); w.z = pk2(v1[0], v1[1]); w.w = pk2(v1[2], v1[3]);
                    *(v4u*)(Y + (size_t)row * 1024 + u.pn * 256 + bj * 128 + wc * 32 + 8 * fq) = w;
                }
                q += __shfl_xor(q, 16); q += __shfl_xor(q, 32);
                if (fq == 0) ssq[(size_t)row * 16 + u.pn * 4 + wc] = q;
            }
    }
};

struct EpiProj {
    static constexpr bool PERM = true, AFTER_DRAIN = false, KSEG = false;
    bf16* O; const float* rstdx;
    DI void operator()(const pg8::f32x4 (&acc)[2][2][4][2], const pg8::Unit& u, int wr, int wc, int fr, int fq) const {
#pragma unroll
        for (int ai = 0; ai < 2; ++ai)
#pragma unroll
            for (int m = 0; m < 4; ++m) {
                const int row = u.pm * 256 + ai * 128 + wr * 64 + m * 16 + fr; const float rs = rstdx[row];
#pragma unroll
                for (int bj = 0; bj < 2; ++bj) {
                    const pg8::f32x4 v0 = acc[ai][bj][m][0] * rs, v1 = acc[ai][bj][m][1] * rs;
                    v4u w; w.x = pk2(v0[0], v0[1]); w.y = pk2(v0[2], v0[3]); w.z = pk2(v1[0], v1[1]); w.w = pk2(v1[2], v1[3]);
                    *(v4u*)(O + (size_t)row * NPROJ + u.pn * 256 + bj * 128 + wc * 32 + 8 * fq) = w;
                }
            }
    }
};
template <class Sched> DI void row_scales(const Sched& S, const float* slots2, float* rstdx, int tid) {
#pragma unroll
    for (int k = 0; k < 6; ++k) {
        pg8::Unit u; const bool ok = S.next((tid >> 8) + 2 * k, u);
        if (ok) {
            const size_t row = (size_t)u.pm * 256 + (tid & 255);
            const v4f s0 = *(const v4f*)(slots2 + row * 16), s1 = *(const v4f*)(slots2 + row * 16 + 4), s2 = *(const v4f*)(slots2 + row * 16 + 8), s3 = *(const v4f*)(slots2 + row * 16 + 12);
            const float s = (((s0[0] + s0[1]) + (s0[2] + s0[3])) + ((s1[0] + s1[1]) + (s1[2] + s1[3]))) + (((s2[0] + s2[1]) + (s2[2] + s2[3])) + ((s3[0] + s3[1]) + (s3[2] + s3[3])));
            rstdx[row] = rsqrtf(s * (1.0f / 1024.0f) + EPS);
        }
    }
    asm volatile("s_waitcnt vmcnt(0)" ::: "memory");
    __syncthreads();
}

DI bf16* a_row(unsigned char* ws, int row) {
    const int gb = row >> 12, s = row & 4095;
    return (bf16*)(s < 2816 ? ws + WS_PROJ + ((size_t)gb << 24) + (size_t)s * (DFF * 2) : ws + WS_MIX + ((size_t)gb << 23) + (size_t)(s - 2816) * (DFF * 2));
}
struct EpiConv {
    static constexpr bool PERM = true, AFTER_DRAIN = false, KSEG = false;
    unsigned char* wsb; const float* cwp; float* gside; LAS unsigned char* halo; const float* rstdx;
    DI void operator()(pg8::f32x4 (&acc)[2][2][4][2], const pg8::Unit& u, int wr, int wc, int fr, int fq) const {
        LAS v4f* H = (LAS v4f*)halo;
#pragma unroll
        for (int ai = 0; ai < 2; ++ai)
#pragma unroll
            for (int m = 0; m < 4; ++m) {
                const float rs = rstdx[u.pm * 256 + ai * 128 + wr * 64 + m * 16 + fr];
#pragma unroll
                for (int bj = 0; bj < 2; ++bj)
#pragma unroll
                    for (int n = 0; n < 2; ++n) acc[ai][bj][m][n] = acc[ai][bj][m][n] * rs;
            }
        const int hl = (fr & 1) + 2 * fq;
        if (fr >= 14) {
#pragma unroll
            for (int ai = 0; ai < 2; ++ai)
#pragma unroll
                for (int bj = 0; bj < 2; ++bj)
#pragma unroll
                    for (int n = 0; n < 2; ++n) { const pg8::f32x4 v = acc[ai][bj][3][n]; H[(((ai * 2 + wr) * 4 + wc) * 4 + bj * 2 + n) * 8 + hl] = (v4f){v[0], v[1], v[2], v[3]}; }
        }
        if (wr == 1 && fr >= 14) {
#pragma unroll
            for (int bj = 0; bj < 2; ++bj)
#pragma unroll
                for (int n = 0; n < 2; ++n) { const pg8::f32x4 v = acc[1][bj][3][n]; *(v4f*)(gside + (size_t)(u.pm * 4 + 2 + (fr - 14)) * NUP + u.pn * 256 + bj * 128 + wc * 32 + 8 * fq + 4 * n) = (v4f){v[0], v[1], v[2], v[3]}; }
        }
        if (wr == 0 && fr < 2) {
#pragma unroll
            for (int bj = 0; bj < 2; ++bj)
#pragma unroll
                for (int n = 0; n < 2; ++n) { const pg8::f32x4 v = acc[0][bj][0][n]; *(v4f*)(gside + (size_t)(u.pm * 4 + fr) * NUP + u.pn * 256 + bj * 128 + wc * 32 + 8 * fq + 4 * n) = (v4f){v[0], v[1], v[2], v[3]}; }
        }
        asm volatile("s_waitcnt lgkmcnt(0)\n\ts_barrier" ::: "memory");
#pragma unroll
        for (int n = 0; n < 2; ++n) {
            v4f w0[2], w1[2], w2[2], cb[2];
#pragma unroll
            for (int bj = 0; bj < 2; ++bj) {
                const float* p = cwp + u.pn * 256 + bj * 128 + wc * 32 + 8 * fq + 4 * n;
                w0[bj] = *(const v4f*)p; w1[bj] = *(const v4f*)(p + NUP); w2[bj] = *(const v4f*)(p + 2 * NUP); cb[bj] = *(const v4f*)(p + 3 * NUP);
            }
#pragma unroll
            for (int ai = 0; ai < 2; ++ai) {
                v4f hal[2];
                {
                    const bool has = (wr == 1) || (ai == 1);
                    const int as = (wr == 1) ? ai : 0, ws_ = (wr == 1) ? 0 : 1;
#pragma unroll
                    for (int bj = 0; bj < 2; ++bj) { v4f hv = H[(((as * 2 + ws_) * 4 + wc) * 4 + bj * 2 + n) * 8 + hl]; hal[bj] = has ? hv : (v4f){0.f, 0.f, 0.f, 0.f}; }
                }
#pragma unroll
                for (int m = 0; m < 4; ++m) {
                    float cv[2][4];
#pragma unroll
                    for (int bj = 0; bj < 2; ++bj) {
                        const pg8::f32x4 cur = acc[ai][bj][m][n];
                        pg8::f32x4 prv;
                        if (m > 0) prv = acc[ai][bj][m > 0 ? m - 1 : 0][n]; else prv = (pg8::f32x4){hal[bj][0], hal[bj][1], hal[bj][2], hal[bj][3]};
#pragma unroll
                        for (int i = 0; i < 4; ++i) {
                            const float q1 = dppf<0x121>(prv[i]), q2 = dppf<0x122>(prv[i]);
                            const float p1 = __int_as_float(__builtin_amdgcn_update_dpp(__float_as_int(q1), __float_as_int(cur[i]), 0x111, 0xf, 0xf, false));
                            const float p2 = __int_as_float(__builtin_amdgcn_update_dpp(__float_as_int(q2), __float_as_int(cur[i]), 0x112, 0xf, 0xf, false));
                            cv[bj][i] = cb[bj][i] + w0[bj][i] * p2 + w1[bj][i] * p1 + w2[bj][i] * cur[i];
                        }
                    }
                    float o[4];
#pragma unroll
                    for (int i = 0; i < 4; ++i) o[i] = gelu_tanh(cv[0][i]) * cv[1][i];
                    const int row = u.pm * 256 + ai * 128 + wr * 64 + m * 16 + fr;
                    v2u w; w.x = pk2(o[0], o[1]); w.y = pk2(o[2], o[3]);
                    *(v2u*)(a_row(wsb, row) + u.pn * 128 + wc * 32 + 8 * fq + 4 * n) = w;
                }
            }
        }
    }
};

#define XB_TMO      128
#define XB_XCNT(j)  (256  + 64 * (j))
#define XB_XSUB(j)  (1280 + 64 * (j))
#define XB_XGEN(j)  (2304 + 64 * (j))
#define XB_TOP      3328
#define XB_TOPGEN   3392
#define XCD_BAR_WORDS 3456
#define XB_SPIN_CAP (1u << 18)

__device__ __forceinline__ unsigned xb_ld(unsigned* p)              { return __hip_atomic_load(p, __ATOMIC_RELAXED, __HIP_MEMORY_SCOPE_AGENT); }
__device__ __forceinline__ unsigned xb_add(unsigned* p, unsigned v) { return __hip_atomic_fetch_add(p, v, __ATOMIC_RELAXED, __HIP_MEMORY_SCOPE_AGENT); }
__device__ __forceinline__ unsigned xb_xcc_id() { return (unsigned)__builtin_amdgcn_s_getreg((3 << 11) | 20) & 0xFu; }
#define XB_SPIN(cond, bar) do { unsigned _sp = 0; while (cond) { __builtin_amdgcn_s_sleep(1); \
    if ((++_sp & 255u) == 0u) { if (xb_ld(&(bar)[XB_TMO])) break; if (_sp > XB_SPIN_CAP) { atomicAdd(&(bar)[XB_TMO], 1u); break; } } } } while (0)

struct XcdBarrier {
    unsigned* bar; unsigned x;
    volatile LAS unsigned* st;
};

__device__ __forceinline__ XcdBarrier xcd_barrier_post(unsigned* bar, volatile LAS unsigned* st, int xtid) {
    XcdBarrier b; b.bar = bar; b.x = xb_xcc_id(); b.st = st;
    if (xtid == 0) (void)xb_add(&bar[XB_XCNT(b.x)], 1u);
    return b;
}
__device__ __forceinline__ void xcd_barrier_complete(unsigned* bar, unsigned x, unsigned& nloc, unsigned& nx) {
    const unsigned G = gridDim.x * gridDim.y * gridDim.z;
    unsigned sum, cnt, mine, sp = 0u;
    for (;;) {
        sum = 0u; cnt = 0u; mine = 0u;
#pragma unroll
        for (unsigned j = 0; j < 16; ++j) { const unsigned c = xb_ld(&bar[XB_XCNT(j)]); sum += c; cnt += (c > 0u) ? 1u : 0u; mine = (j == x) ? c : mine; }
        if (sum == G) break;
        __builtin_amdgcn_s_sleep(1);
        if ((++sp & 255u) == 0u) { if (xb_ld(&bar[XB_TMO])) break; if (sp > XB_SPIN_CAP) { atomicAdd(&bar[XB_TMO], 1u); break; } }
    }
    nloc = mine > 0u ? mine : 1u; nx = cnt > 0u ? cnt : 1u;
}

__device__ __forceinline__ void xcd_barrier(const XcdBarrier& b, int xtid) {
    asm volatile("s_waitcnt vmcnt(0)" ::: "memory");
    __syncthreads();
    if (xtid == 0) {
        unsigned* bar = b.bar;
        __builtin_amdgcn_s_waitcnt(0);
        unsigned nloc = b.st[0], nx = b.st[1];
        if (nloc == 0u) { xcd_barrier_complete(bar, b.x, nloc, nx); b.st[0] = nloc; b.st[1] = nx; }
        const unsigned old = xb_add(&bar[XB_XSUB(b.x)], 1u);
        const unsigned gen = old / nloc;
        if (old + 1u == (gen + 1u) * nloc) {
            __builtin_amdgcn_fence(__ATOMIC_RELEASE, "agent");
            asm volatile("s_waitcnt vmcnt(0)" ::: "memory");
            const unsigned og = xb_add(&bar[XB_TOP], 1u);
            const unsigned tg = og / nx;
            if (og + 1u == (tg + 1u) * nx) xb_add(&bar[XB_TOPGEN], 1u);
            else XB_SPIN(xb_ld(&bar[XB_TOPGEN]) == tg, bar);
            __builtin_amdgcn_fence(__ATOMIC_ACQUIRE, "agent");
            xb_add(&bar[XB_XGEN(b.x)], 1u);
            asm volatile("s_waitcnt vmcnt(0)" ::: "memory");
        } else {
            XB_SPIN(xb_ld(&bar[XB_XGEN(b.x)]) == gen, bar);
            __builtin_amdgcn_fence(__ATOMIC_ACQUIRE, "agent");
            asm volatile("s_waitcnt vmcnt(0)" ::: "memory");
        }
    }
    __syncthreads();
}

template <int MAP> DI int srccol(int n) {
    if (MAP == 0) return n;
    if (MAP == 1) return n < 1536 ? n : (n < 1952 ? n + 4 : (n < 1956 ? n - 416 : -1));
    if (MAP == 2) { const int pn = n >> 8, bj = (n >> 7) & 1, jj = n & 127; return bj * DFF + pn * 128 + jj; }
    { const int v = n >> 8, h = (n >> 6) & 3, j = n & 63; return h * 128 + v * 64 + j; }
}
template <int MAP> DI void cvt_item(const float* W, int K, int Nsrc, bf16* WT, int Ndst, const float* kgain, float scale, LAS float* scr, int item, int lane) {
    const int nblk = Ndst / 32, kb = item / nblk, nb = item % nblk, k0 = 64 * kb, n0 = 32 * nb;
    const int c4 = lane & 7, n4 = n0 + 4 * c4, sc = srccol<MAP>(n4);
    float cs = scale; if (MAP == 1) { cs = (n4 < 512 || (n4 >= 768 && n4 < 1024)) ? scale : 1.f; }
    v4f wv[8];
#pragma unroll
    for (int jx = 0; jx < 8; ++jx) { const int kk = (lane >> 3) + 8 * jx; wv[jx] = (sc >= 0) ? *(const v4f*)(W + (size_t)(k0 + kk) * Nsrc + sc) : (v4f){0.f, 0.f, 0.f, 0.f}; }
#pragma unroll
    for (int jx = 0; jx < 8; ++jx) {
        const int kk = (lane >> 3) + 8 * jx;
        float g = cs; if (kgain) g *= kgain[k0 + kk];
        LAS float* d = scr + kk * 33 + 4 * c4;
        d[0] = wv[jx][0] * g; d[1] = wv[jx][1] * g; d[2] = wv[jx][2] * g; d[3] = wv[jx][3] * g;
    }
    asm volatile("s_waitcnt lgkmcnt(0)" ::: "memory");
    const int c = lane & 7;
#pragma unroll
    for (int j = 0; j < 4; ++j) {
        const int nn = (lane >> 3) + 8 * j; const LAS float* s = scr + (8 * c) * 33 + nn;
        v4u o; o.x = pk2(s[0 * 33], s[1 * 33]); o.y = pk2(s[2 * 33], s[3 * 33]); o.z = pk2(s[4 * 33], s[5 * 33]); o.w = pk2(s[6 * 33], s[7 * 33]);
        *(v4u*)(WT + (size_t)(n0 + nn) * K + k0 + 8 * c) = o;
    }
    asm volatile("s_waitcnt lgkmcnt(0)" ::: "memory");
}

DI void row_update(float* xrow, const float* xin, const bf16* yrow, float* ssqp, const float* gpost, const float* gpre, bf16* hrow, int lane) {
    v4f v[4];
    const v4f* src = (const v4f*)(xin ? xin : xrow) + lane;
#pragma unroll
    for (int j = 0; j < 4; ++j) v[j] = src[64 * j];
    if (yrow) {
        const v4f s0 = *(const v4f*)ssqp, s1 = *(const v4f*)(ssqp + 4), s2 = *(const v4f*)(ssqp + 8), s3 = *(const v4f*)(ssqp + 12);
        const float sy = (((s0[0] + s0[1]) + (s0[2] + s0[3])) + ((s1[0] + s1[1]) + (s1[2] + s1[3]))) + (((s2[0] + s2[1]) + (s2[2] + s2[3])) + ((s3[0] + s3[1]) + (s3[2] + s3[3])));
        const float rsy = rsqrtf(sy * (1.0f / 1024.0f) + EPS);
        const v2u* yp = (const v2u*)yrow + lane;
#pragma unroll
        for (int j = 0; j < 4; ++j) {
            const v2u y = yp[64 * j]; const v4f g = ((const v4f*)gpost)[lane + 64 * j];
            v[j][0] += bflo(y.x) * rsy * g[0]; v[j][1] += bfhi(y.x) * rsy * g[1]; v[j][2] += bflo(y.y) * rsy * g[2]; v[j][3] += bfhi(y.y) * rsy * g[3];
        }
    }
    {
        v4f* dst = (v4f*)xrow + lane;
#pragma unroll
        for (int j = 0; j < 4; ++j) dst[64 * j] = v[j];
    }
    if (gpre) {
        float s = 0.f;
#pragma unroll
        for (int j = 0; j < 4; ++j) s += (v[j][0] * v[j][0] + v[j][1] * v[j][1]) + (v[j][2] * v[j][2] + v[j][3] * v[j][3]);
        const float rs = rsqrtf(wave_sum(s) * (1.0f / 1024.0f) + EPS);
        v2u* hp = (v2u*)hrow + lane;
#pragma unroll
        for (int j = 0; j < 4; ++j) {
            const v4f g = ((const v4f*)gpre)[lane + 64 * j];
            v2u w; w.x = pk2(v[j][0] * rs * g[0], v[j][1] * rs * g[1]); w.y = pk2(v[j][2] * rs * g[2], v[j][3] * rs * g[3]);
            hp[64 * j] = w;
        }
    }
}

struct RowExchange {
    float* slots; unsigned* cnt; unsigned* tmo; bool local;
    DI void run(const float (&part)[2][4], const pg8::Unit& u, int wr, int wc, int fr, int fq, int wid, int lane, LAS float* S, volatile LAS unsigned* flag) const {
        if (fq == 0) {
#pragma unroll
            for (int ai = 0; ai < 2; ++ai)
#pragma unroll
                for (int m = 0; m < 4; ++m) {
                    const int row = u.pm * 256 + ai * 128 + wr * 64 + m * 16 + fr;
                    __hip_atomic_store((unsigned*)slots + (size_t)row * 16 + u.pn * 4 + wc, __float_as_uint(part[ai][m]), __ATOMIC_RELAXED, __HIP_MEMORY_SCOPE_AGENT);
                }
        }
        asm volatile("s_waitcnt vmcnt(0)" ::: "memory");
        if (lane == 0) __hip_atomic_fetch_add(cnt + 64 * u.pm, 1u, __ATOMIC_RELAXED, __HIP_MEMORY_SCOPE_AGENT);
        if (wid == 0) {
            unsigned sp = 0;
            for (;;) {
                if ((unsigned)__builtin_amdgcn_readfirstlane(__hip_atomic_load(cnt + 64 * u.pm, __ATOMIC_RELAXED, __HIP_MEMORY_SCOPE_AGENT)) >= 32u) break;
                __builtin_amdgcn_s_sleep(2);
                if (++sp > (1u << 20)) { if (lane == 0) __hip_atomic_store(tmo, 1u, __ATOMIC_RELAXED, __HIP_MEMORY_SCOPE_AGENT); break; }
            }
            __builtin_amdgcn_fence(__ATOMIC_ACQUIRE, "agent");
        }
        asm volatile("s_waitcnt vmcnt(0) lgkmcnt(0)" ::: "memory"); __builtin_amdgcn_s_barrier(); asm volatile("" ::: "memory");
        int ln = lane; asm volatile("" : "+v"(ln));
        if (ln < 32) {
            const int r = wid * 32 + ln;
            const unsigned* sl = (const unsigned*)slots + (size_t)(u.pm * 256 + r) * 16;
            float v[16];
            if (local) {
                const v4f q0 = ((const v4f*)sl)[0], q1 = ((const v4f*)sl)[1], q2 = ((const v4f*)sl)[2], q3 = ((const v4f*)sl)[3];
#pragma unroll
                for (int k = 0; k < 4; ++k) { v[k] = q0[k]; v[4 + k] = q1[k]; v[8 + k] = q2[k]; v[12 + k] = q3[k]; }
            } else {
#pragma unroll
                for (int k = 0; k < 16; ++k) v[k] = __uint_as_float(__hip_atomic_load(sl + k, __ATOMIC_RELAXED, __HIP_MEMORY_SCOPE_AGENT));
            }
            const float s = (((v[0] + v[1]) + (v[2] + v[3])) + ((v[4] + v[5]) + (v[6] + v[7]))) + (((v[8] + v[9]) + (v[10] + v[11])) + ((v[12] + v[13]) + (v[14] + v[15])));
            S[r] = rsqrtf(s * (1.0f / 1024.0f) + EPS);
        }
        asm volatile("s_waitcnt lgkmcnt(0)" ::: "memory"); __builtin_amdgcn_s_barrier(); asm volatile("" ::: "memory");
    }
};
template <bool KSEG_> struct EpiRes {
    static constexpr bool PERM = true, AFTER_DRAIN = false, KSEG = KSEG_;
    AP a; int l; LAS unsigned char* fsl; int pm0, pn0; bool local;
    DI int ordinal(const pg8::Unit& u) const { return (u.pm == pm0 && u.pn == pn0) ? 0 : 1; }
    DI void kscale(pg8::f32x4 (&acc)[2][2][4][2], int seg, const pg8::Unit& u, int wr, int fr) const {
        const LAS float* F = (const LAS float*)fsl + (ordinal(u) * 3 + ((seg == 1) ? 0 : 1)) * 256 + wr * 64 + fr;
#pragma unroll
        for (int ai = 0; ai < 2; ++ai)
#pragma unroll
            for (int m = 0; m < 4; ++m) {
                const float f = F[ai * 128 + m * 16];
#pragma unroll
                for (int bj = 0; bj < 2; ++bj)
#pragma unroll
                    for (int n = 0; n < 2; ++n) acc[ai][bj][m][n] = acc[ai][bj][m][n] * f;
            }
    }
    DI void operator()(pg8::f32x4 (&acc)[2][2][4][2], const pg8::Unit& u, int wr, int wc, int fr, int fq) const {
        const int wid = wr * 4 + wc, lane = fr + 16 * fq;
        AP ap = a; asm volatile("" : "+s"(ap));
        unsigned char* ws = ap->ws; bf16* XB = (bf16*)(ws + WS_HB);
        const float* gpost = ap->in[KSEG ? I_APOST : I_FPOST] + l * 1024;
        const bool last = (!KSEG) && (l + 1 == DEPTH);
        float* OUT = ap->out;
        unsigned* cb = (unsigned*)(ws + WS_CTL + CTL_CNT_OFF) + (size_t)(l * 4 + (KSEG ? 0 : 2)) * 128 * 64;
        const RowExchange ex1{(float*)(ws + WS_SSQY), cb, (unsigned*)(ws + WS_CTL) + XB_TMO, local};
        float* slots2 = (float*)(ws + WS_SLOT2);
        LAS unsigned char* xl = fsl + 12288;
        LAS float* S = (LAS float*)xl; volatile LAS unsigned* flag = (volatile LAS unsigned*)(xl + 1024);
        float part[2][4];
#pragma unroll
        for (int ai = 0; ai < 2; ++ai)
#pragma unroll
            for (int m = 0; m < 4; ++m) {
                if (KSEG) { const float sc = ((const LAS float*)fsl)[(ordinal(u) * 3 + 2) * 256 + ai * 128 + wr * 64 + m * 16 + fr];
#pragma unroll
                    for (int bj = 0; bj < 2; ++bj)
#pragma unroll
                        for (int n = 0; n < 2; ++n) acc[ai][bj][m][n] = acc[ai][bj][m][n] * sc; }
                float q = 0.f;
#pragma unroll
                for (int bj = 0; bj < 2; ++bj)
#pragma unroll
                    for (int n = 0; n < 2; ++n) { const pg8::f32x4 v = acc[ai][bj][m][n]; q += (v[0] * v[0] + v[1] * v[1]) + (v[2] * v[2] + v[3] * v[3]); }
                q += __shfl_xor(q, 16); q += __shfl_xor(q, 32);
                part[ai][m] = q;
            }
        ex1.run(part, u, wr, wc, fr, fq, wid, lane, S, flag);
        const int colb = u.pn * 256 + wc * 32 + 8 * fq;
#pragma unroll
        for (int ai = 0; ai < 2; ++ai)
#pragma unroll
            for (int m = 0; m < 4; ++m) {
                const int rl = ai * 128 + wr * 64 + m * 16 + fr; const float r1 = S[rl];
                const size_t ro = (size_t)(u.pm * 256 + rl) * 1024 + colb;
                float q = 0.f;
#pragma unroll
                for (int bj = 0; bj < 2; ++bj) {
                    const v4u xw = *(const v4u*)(XB + ro + bj * 128);
                    const v4f g0 = *(const v4f*)(gpost + colb + bj * 128), g1 = *(const v4f*)(gpost + colb + bj * 128 + 4);
                    const pg8::f32x4 a0 = acc[ai][bj][m][0], a1 = acc[ai][bj][m][1];
                    float v[8];
                    v[0] = bflo(xw.x) + a0[0] * r1 * g0[0]; v[1] = bfhi(xw.x) + a0[1] * r1 * g0[1]; v[2] = bflo(xw.y) + a0[2] * r1 * g0[2]; v[3] = bfhi(xw.y) + a0[3] * r1 * g0[3];
                    v[4] = bflo(xw.z) + a1[0] * r1 * g1[0]; v[5] = bfhi(xw.z) + a1[1] * r1 * g1[1]; v[6] = bflo(xw.w) + a1[2] * r1 * g1[2]; v[7] = bfhi(xw.w) + a1[3] * r1 * g1[3];
                    q += ((v[0] * v[0] + v[1] * v[1]) + (v[2] * v[2] + v[3] * v[3])) + ((v[4] * v[4] + v[5] * v[5]) + (v[6] * v[6] + v[7] * v[7]));
                    if (last) { *(v4f*)(OUT + ro + bj * 128) = (v4f){v[0], v[1], v[2], v[3]}; *(v4f*)(OUT + ro + bj * 128 + 4) = (v4f){v[4], v[5], v[6], v[7]}; }
                    else { v4u w; w.x = pk2(v[0], v[1]); w.y = pk2(v[2], v[3]); w.z = pk2(v[4], v[5]); w.w = pk2(v[6], v[7]); *(v4u*)(XB + ro + bj * 128) = w; }
                }
                q += __shfl_xor(q, 16); q += __shfl_xor(q, 32);
                if (fq == 0) slots2[(size_t)(u.pm * 256 + rl) * 16 + u.pn * 4 + wc] = q;
                if (m & 1) asm volatile("" ::: "memory");
            }
        asm volatile("s_waitcnt lgkmcnt(0)" ::: "memory"); __builtin_amdgcn_s_barrier(); asm volatile("" ::: "memory");
    }
};

DI void seam_factors(const float* ssqg, int pm, LAS float* F, int tid) {
    if (tid < 256) {
        const size_t row = (size_t)pm * 256 + tid;
        const v4f s0 = *(const v4f*)(ssqg + row * 16), s1 = *(const v4f*)(ssqg + row * 16 + 4), s2 = *(const v4f*)(ssqg + row * 16 + 8), s3 = *(const v4f*)(ssqg + row * 16 + 12);
        const float qa = ((s0[0] + s0[1]) + (s0[2] + s0[3])) + ((s1[0] + s1[1]) + (s1[2] + s1[3])), qb = (s2[0] + s2[1]) + (s2[2] + s2[3]), qc = (s3[0] + s3[1]) + (s3[2] + s3[3]);
        const float vb = qb * (1.0f / 256.0f) + EPS, vc = qc * (1.0f / 256.0f) + EPS;
        const float ra = rsqrtf(qa * (1.0f / 512.0f) + EPS), rb = rsqrtf(vb), rc = rsqrtf(vc);
        F[tid] = ra * (vb * rb); F[256 + tid] = rb * (vc * rc); F[512 + tid] = rc;
    }
}

#define MFMA32(a, b, c) __builtin_amdgcn_mfma_f32_32x32x16_bf16((a), (b), (c), 0, 0, 0)

DI void prep_unit(AP a, int l, int unit, LAS unsigned char* lds, int tid, int lane, int wave) {
    unsigned char* ws = a->ws;
    const bf16* proj = (const bf16*)(ws + WS_PROJ);
    const bf16* Wuq = (const bf16*)(ws + WS_W + (size_t)l * W_LAYER + WO_UQ);
    const bf16* Wukv = (const bf16*)(ws + WS_W + (size_t)l * W_LAYER + WO_UKV);
    bf16* qm = (bf16*)(ws + WS_QM); bf16* km = (bf16*)(ws + WS_KM);
    bf16* vts = (bf16*)(ws + WS_VTS); bf16* vtf = (bf16*)(ws + WS_VTF); bf16* vtm = (bf16*)(ws + WS_VTM);
    const float* rope = (const float*)(ws + WS_ROPE);
    const int t0 = unit * 128, b = t0 / SEQ, s0 = t0 % SEQ;
    const int rb = wave & 3, half = wave >> 2, r32 = lane & 31, hi = lane >> 5;
    const int row = t0 + 32 * rb + r32, pos = s0 + 32 * rb + r32;
    {
        constexpr int WSZ = 32 * 528;
        LAS unsigned char* wb = lds + 1024 + half * 2 * WSZ;
        const int ht = tid & 255;
        v8s bq[16], bk[8]; float ssq_ = 0.f, ssk_ = 0.f;
#pragma unroll
        for (int ks = 0; ks < 16; ++ks) {
            bq[ks] = *(const v8s*)(proj + (size_t)row * NPROJ + C_CQ + 16 * ks + 8 * hi);
#pragma unroll
            for (int jx = 0; jx < 8; ++jx) { const float f = bf2f((unsigned short)bq[ks][jx]); ssq_ += f * f; }
        }
#pragma unroll
        for (int ks = 0; ks < 8; ++ks) {
            bk[ks] = *(const v8s*)(proj + (size_t)row * NPROJ + C_CKV + 16 * ks + 8 * hi);
#pragma unroll
            for (int jx = 0; jx < 8; ++jx) { const float f = bf2f((unsigned short)bk[ks][jx]); ssk_ += f * f; }
        }
        ssq_ += __shfl_xor(ssq_, 32); ssk_ += __shfl_xor(ssk_, 32);
        const float rstdq = rsqrtf(ssq_ * (1.0f / 256.0f) + EPS), rstdk = rsqrtf(ssk_ * (1.0f / 128.0f) + EPS);
        v4u wreg[4];
#define PW_LOAD(st) do { if ((st) < 6) { const bf16* src_ = Wuq + (size_t)(32 * (half * 6 + (st))) * 256; \
            _Pragma("unroll") for (int jx = 0; jx < 4; ++jx) { const int p_ = ht + 256 * jx; wreg[jx] = *(const v4u*)(src_ + (size_t)(p_ >> 5) * 256 + 8 * (p_ & 31)); } } \
        else { const bf16* src_ = Wukv + (size_t)(32 * (half * 8 + (st) - 6)) * 128; \
            _Pragma("unroll") for (int jx = 0; jx < 2; ++jx) { const int p_ = ht + 256 * jx; wreg[jx] = *(const v4u*)(src_ + (size_t)(p_ >> 4) * 128 + 8 * (p_ & 15)); } } } while (0)
#define PW_STORE(st, bf_) do { LAS unsigned char* d_ = wb + (bf_) * WSZ; if ((st) < 6) { \
            _Pragma("unroll") for (int jx = 0; jx < 4; ++jx) { const int p_ = ht + 256 * jx; *(LAS v4u*)(d_ + (p_ >> 5) * 528 + 16 * (p_ & 31)) = wreg[jx]; } } \
        else { _Pragma("unroll") for (int jx = 0; jx < 2; ++jx) { const int p_ = ht + 256 * jx; *(LAS v4u*)(d_ + (p_ >> 4) * 528 + 16 * (p_ & 15)) = wreg[jx]; } } } while (0)
        __syncthreads();
        PW_LOAD(0); PW_STORE(0, 0);
        __syncthreads();
#pragma unroll 1
        for (int st = 0; st < 14; ++st) {
            if (st + 1 < 14) PW_LOAD(st + 1);
            const LAS unsigned char* wp = wb + (st & 1) * WSZ + r32 * 528 + 16 * hi;
            v16f acc = {};
            if (st < 6) {
                const int cb = half * 6 + st;
#pragma unroll
                for (int ks = 0; ks < 16; ++ks) { const v8s af = *(const LAS v8s*)(wp + 32 * ks); acc = MFMA32(af, bq[ks], acc); }
#pragma unroll
                for (int r = 0; r < 16; ++r) acc[r] *= rstdq;
                if (st % 3 == 2) {
                    const v4f c0 = *(const v4f*)(rope + (size_t)pos * 32 + 4 * hi), c1 = *(const v4f*)(rope + (size_t)pos * 32 + 8 + 4 * hi);
                    const v4f s0v = *(const v4f*)(rope + (size_t)pos * 32 + 16 + 4 * hi), s1v = *(const v4f*)(rope + (size_t)pos * 32 + 24 + 4 * hi);
#pragma unroll
                    for (int r = 0; r < 8; ++r) {
                        const float c = (r < 4) ? c0[r & 3] : c1[r & 3], s = (r < 4) ? s0v[r & 3] : s1v[r & 3];
                        const float x1 = acc[r], x2 = acc[r + 8];
                        acc[r] = x1 * c - x2 * s; acc[r + 8] = x1 * s + x2 * c;
                    }
                }
#pragma unroll
                for (int g = 0; g < 4; ++g) { v2u w; w.x = pk2(acc[4 * g], acc[4 * g + 1]); w.y = pk2(acc[4 * g + 2], acc[4 * g + 3]); *(v2u*)(qm + (size_t)row * 384 + 32 * cb + 8 * g + 4 * hi) = w; }
            } else {
                const int cbi = st - 6;
#pragma unroll
                for (int ks = 0; ks < 8; ++ks) { const v8s af = *(const LAS v8s*)(wp + 32 * ks); acc = MFMA32(af, bk[ks], acc); }
#pragma unroll
                for (int r = 0; r < 16; ++r) acc[r] *= rstdk;
                const int head = cbi >> 1, off = 32 * (cbi & 1);
                if (half == 0) {
#pragma unroll
                    for (int g = 0; g < 4; ++g) { v2u w; w.x = pk2(acc[4 * g], acc[4 * g + 1]); w.y = pk2(acc[4 * g + 2], acc[4 * g + 3]); *(v2u*)(km + (size_t)row * 384 + 96 * head + off + 8 * g + 4 * hi) = w; }
                } else {
#pragma unroll
                    for (int r = 0; r < 16; ++r) { const int d = off + crow(r, hi); vtm[((size_t)(b * 4 + head) * 64 + d) * SEQ + pos] = (bf16)(pk2(acc[r], 0.f) & 0xffffu); }
                }
            }
            if (st + 1 < 14) PW_STORE(st + 1, (st + 1) & 1);
            __syncthreads();
        }
#undef PW_LOAD
#undef PW_STORE
    }
    {
        const int rl = tid >> 2, q4 = tid & 3; const int rw = t0 + rl, ps = s0 + rl;
        const v2u x1 = *(const v2u*)(proj + (size_t)rw * NPROJ + C_KR + 4 * q4), x2 = *(const v2u*)(proj + (size_t)rw * NPROJ + C_KR + 16 + 4 * q4);
        const v4f c = *(const v4f*)(rope + (size_t)ps * 32 + 4 * q4), s = *(const v4f*)(rope + (size_t)ps * 32 + 16 + 4 * q4);
        const float a1[4] = {bflo(x1.x), bfhi(x1.x), bflo(x1.y), bfhi(x1.y)}, a2[4] = {bflo(x2.x), bfhi(x2.x), bflo(x2.y), bfhi(x2.y)};
        float o1[4], o2[4];
#pragma unroll
        for (int i = 0; i < 4; ++i) { o1[i] = a1[i] * c[i] - a2[i] * s[i]; o2[i] = a1[i] * s[i] + a2[i] * c[i]; }
        v2u w1, w2; w1.x = pk2(o1[0], o1[1]); w1.y = pk2(o1[2], o1[3]); w2.x = pk2(o2[0], o2[1]); w2.y = pk2(o2[2], o2[3]);
#pragma unroll
        for (int h = 0; h < 4; ++h) { *(v2u*)(km + (size_t)rw * 384 + 96 * h + 64 + 4 * q4) = w1; *(v2u*)(km + (size_t)rw * 384 + 96 * h + 80 + 4 * q4) = w2; }
    }
#pragma unroll 4
    for (int k = 0; k < 12; ++k) {
        const int it = tid + 512 * k, c = it % 384, rg = it / 384;
        const int src = c < 128 ? C_SWAV + c : C_FOXV + (c - 128);
        unsigned short e[8];
#pragma unroll
        for (int j = 0; j < 8; ++j) e[j] = proj[(size_t)(t0 + 8 * rg + j) * NPROJ + src];
        v4u w; w.x = e[0] | ((unsigned)e[1] << 16); w.y = e[2] | ((unsigned)e[3] << 16); w.z = e[4] | ((unsigned)e[5] << 16); w.w = e[6] | ((unsigned)e[7] << 16);
        bf16* dst = c < 128 ? vts + ((size_t)(b * 2 + (c >> 6)) * 64 + (c & 63)) * SEQ : vtf + ((size_t)(b * 4 + ((c - 128) >> 6)) * 64 + ((c - 128) & 63)) * SEQ;
        *(v4u*)(dst + s0 + 8 * rg) = w;
    }
    {
        const int tk = tid >> 2, h = tid & 3;
        const v4u* kp = (const v4u*)(proj + (size_t)(t0 + tk) * NPROJ + C_FOXK + 64 * h);
        float ss = 0.f;
#pragma unroll
        for (int i = 0; i < 8; ++i) { const v4u w = kp[i]; const unsigned e[4] = {w.x, w.y, w.z, w.w};
#pragma unroll
            for (int j = 0; j < 4; ++j) { const float lo = bflo(e[j]), hi2 = bfhi(e[j]); ss += lo * lo + hi2 * hi2; } }
        float nm = sqrtf(ss);
#pragma unroll
        for (int o = 4; o < 64; o <<= 1) nm = fmaxf(nm, __shfl_xor(nm, o));
        LAS float* red = (LAS float*)lds;
        __syncthreads();
        if (lane < 4) red[wave * 4 + lane] = nm;
        __syncthreads();
        if (tid < 4) { float mx = red[tid]; for (int w = 1; w < 8; ++w) mx = fmaxf(mx, red[w * 4 + tid]); ((float*)(ws + WS_KNMAX))[(size_t)unit * 4 + tid] = mx; }
    }
    if (wave == 7) {
        const float* fb = a->in[I_FB] + l * 4;
        float* floc = (float*)(ws + WS_FLOC); float* ftot = (float*)(ws + WS_FTOT);
        const int r0 = t0 + 2 * lane;
        const v2u z0 = *(const v2u*)(proj + (size_t)r0 * NPROJ + C_FL), z1 = *(const v2u*)(proj + (size_t)(r0 + 1) * NPROJ + C_FL);
        const float za[4] = {bflo(z0.x), bfhi(z0.x), bflo(z0.y), bfhi(z0.y)}, zb[4] = {bflo(z1.x), bfhi(z1.x), bflo(z1.y), bfhi(z1.y)};
        v4f o0, o1, tt;
#pragma unroll
        for (int h = 0; h < 4; ++h) {
            const float xa = za[h] + fb[h], xb = zb[h] + fb[h];
            const float la = fminf(xa, 0.f) - __logf(1.0f + __expf(-fabsf(xa))), lb = fminf(xb, 0.f) - __logf(1.0f + __expf(-fabsf(xb)));
            const float tot = la + lb; float sc = tot;
#pragma unroll
            for (int o = 1; o < 64; o <<= 1) { const float v = __shfl_up(sc, o); if (lane >= o) sc += v; }
            const float ex = sc - tot;
            o0[h] = ex + la; o1[h] = ex + tot; tt[h] = sc;
        }
        *(v4f*)(floc + (size_t)r0 * 4) = o0; *(v4f*)(floc + (size_t)(r0 + 1) * 4) = o1;
        if (lane == 63) *(v4f*)(ftot + (size_t)unit * 4) = tt;
    }
}

template <int MODE> DI void attn_unit(int b, int qb, const bf16* Qb, int qpitch, const bf16* Kb, int kpitch, const bf16* VT, bf16* O, float* ssq,
                                      const float* aux, const float* aux2, const float* aux3, int auxstride, LAS unsigned char* lds, int tid, int lane, int wave) {
    constexpr int DK = (MODE == 2) ? 96 : 64, ND = DK / 16, PK = DK * 2 + 16, PCS = DK / 8;
    constexpr int KOFF = 0, KSZ = 64 * PK, VOFF = 2 * KSZ, VSZ = 64 * 136, FOFF = VOFF + 2 * VSZ, MSOFF = FOFF + 512;
    const int r32 = lane & 31, hi = lane >> 5;
    const size_t rowbase = (size_t)b * SEQ;
    const int q0 = qb * 256, qw0 = q0 + 32 * wave, q = qw0 + r32;
    LAS float* MS = (LAS float*)(lds + MSOFF);
    __syncthreads();
    if (MODE == 1) {
        if (wave == 0) {
            float v = (lane < 32) ? aux2[(size_t)lane * 4] : 0.f; const float own = v;
#pragma unroll
            for (int o = 1; o < 32; o <<= 1) { const float t = __shfl_up(v, o); if (lane >= o) v += t; }
            if (lane < 32) MS[lane] = v - own;
        }
        if (wave == 1) {
            float v = (lane < 32) ? aux3[(size_t)lane * 4] : 0.f;
#pragma unroll
            for (int o = 1; o < 32; o <<= 1) { const float t = __shfl_up(v, o); if (lane >= o) v = fmaxf(v, t); }
            if (lane < 32) MS[32 + lane] = v;
        }
    }
    if (MODE == 0) { if (tid < 320) { const int dist = 223 - tid; MS[tid] = ((unsigned)dist < 128u) ? aux[dist & 127] : NEGBIG; } }
    __syncthreads();
    v8s qr[ND];
#pragma unroll
    for (int d0 = 0; d0 < ND; ++d0) qr[d0] = *(const v8s*)(Qb + (rowbase + q) * qpitch + 16 * d0 + 8 * hi);
    const int kt_lo = (MODE == 0) ? (4 * qb - 2 > 0 ? 4 * qb - 2 : 0) : 0, kt_hi = 4 * qb + 3;
    v4u kreg0, kreg1 = {}, vreg; float freg = 0.f;
    const int krow0 = tid / PCS, kc0 = tid % PCS, krow1 = (tid + 512) / PCS, kc1 = (tid + 512) % PCS;
    const int vd = tid >> 3, vc = tid & 7;
#define ATT_LOAD(kt) do { \
        kreg0 = *(const v4u*)(Kb + (rowbase + 64 * (kt) + krow0) * kpitch + 8 * kc0); \
        if (DK == 96 && tid < 256) kreg1 = *(const v4u*)(Kb + (rowbase + 64 * (kt) + krow1) * kpitch + 8 * kc1); \
        vreg = *(const v4u*)(VT + (size_t)vd * SEQ + 64 * (kt) + 8 * vc); \
        if (MODE == 1 && tid < 64) freg = -(aux[(rowbase + 64 * (kt) + tid) * auxstride] + MS[(64 * (kt) + tid) >> 7]) * LOG2E; } while (0)
#define ATT_STORE(buf) do { \
        *(LAS v4u*)(lds + KOFF + (buf) * KSZ + krow0 * PK + 16 * kc0) = kreg0; \
        if (DK == 96 && tid < 256) *(LAS v4u*)(lds + KOFF + (buf) * KSZ + krow1 * PK + 16 * kc1) = kreg1; \
        { LAS unsigned char* vq_ = lds + VOFF + (buf) * VSZ + vd * 136 + 16 * vc; *(LAS v2u*)vq_ = (v2u){vreg.x, vreg.y}; *(LAS v2u*)(vq_ + 8) = (v2u){vreg.z, vreg.w}; } \
        if (MODE == 1 && tid < 64) ((LAS float*)(lds + FOFF + (buf) * 256))[tid] = freg; } while (0)
    constexpr bool REV = (MODE == 1);
    const int ntile = kt_hi - kt_lo + 1;
    float qn = 0.f;
    if (REV) {
#pragma unroll
        for (int d0 = 0; d0 < ND; ++d0)
#pragma unroll
            for (int j = 0; j < 8; ++j) { const float f = bf2f((unsigned short)qr[d0][j]); qn += f * f; }
        qn += __shfl_xor(qn, 32); qn = sqrtf(qn) * 1.01f;
    }
    ATT_LOAD(REV ? kt_hi : kt_lo); ATT_STORE(0);
    __syncthreads();
    float m = (MODE == 0) ? aux2[0] * LOG2E : NEGBIG;
    float lsum = (MODE == 0 && hi == 0) ? 1.f : 0.f;
    v16f o0 = {}, o1 = {};
    int buf = 0;
    bool seen = false;
    for (int it = 0; it < ntile; ++it) {
        const int kt = REV ? kt_hi - it : kt_lo + it;
        const bool more = it + 1 < ntile;
        if (more) ATT_LOAD(REV ? kt - 1 : kt + 1);
        const int k0 = 64 * kt;
        const bool active = (k0 <= qw0 + 31) && (MODE != 0 || k0 + 63 >= qw0 - 127);
        if (active) {
            const LAS unsigned char* kb = lds + KOFF + buf * KSZ + r32 * PK + 16 * hi;
            v16f p0, p1;
#pragma unroll
            for (int d0 = 0; d0 < ND; ++d0) {
                const v8s ka = *(const LAS v8s*)(kb + 32 * d0), kb2 = *(const LAS v8s*)(kb + 32 * PK + 32 * d0);
                if (d0 == 0) { p0 = MFMA32(ka, qr[0], (v16f){}); p1 = MFMA32(kb2, qr[0], (v16f){}); }
                else { p0 = MFMA32(ka, qr[d0], p0); p1 = MFMA32(kb2, qr[d0], p1); }
            }
            asm volatile("s_nop 15\n\ts_nop 7" : "+v"(p0), "+v"(p1));
            if (MODE == 1) {
                const LAS float* fb = (const LAS float*)(lds + FOFF + buf * 256);
#pragma unroll
                for (int g = 0; g < 4; ++g) {
                    const v4f f0 = *(const LAS v4f*)(fb + 8 * g + 4 * hi), f1 = *(const LAS v4f*)(fb + 32 + 8 * g + 4 * hi);
#pragma unroll
                    for (int i = 0; i < 4; ++i) { p0[4 * g + i] += f0[i]; p1[4 * g + i] += f1[i]; }
                }
            }
            if (MODE == 0) {
                const LAS float* tb = MS + (223 - q + k0 + 4 * hi);
#pragma unroll
                for (int r = 0; r < 16; ++r) { p0[r] += tb[(r & 3) + 8 * (r >> 2)]; p1[r] += tb[32 + (r & 3) + 8 * (r >> 2)]; }
            } else if (k0 + 63 > qw0) {
#pragma unroll
                for (int r = 0; r < 16; ++r) {
                    const int kv = k0 + crow(r, hi);
                    if (kv > q) p0[r] = NEGBIG;
                    if (kv + 32 > q) p1[r] = NEGBIG;
                }
            }
            float rm;
            { float ma = max3f(p0[0], p0[1], p1[0]), mb = max3f(p0[2], p0[3], p1[1]); ma = max3f(ma, p1[2], p1[3]);
#pragma unroll
              for (int r = 4; r < 16; r += 4) { ma = max3f(ma, p0[r], p0[r + 1]); mb = max3f(mb, p0[r + 2], p0[r + 3]); ma = max3f(ma, p1[r], p1[r + 1]); mb = max3f(mb, p1[r + 2], p1[r + 3]); }
              rm = max2f(ma, mb); }
            { const auto rr = __builtin_amdgcn_permlane32_swap(__float_as_uint(rm), __float_as_uint(rm), false, false); rm = max2f(__uint_as_float(rr[0]), __uint_as_float(rr[1])); }
            const float mn = max2f(m, rm), corr = __builtin_amdgcn_exp2f(m - mn);
            m = mn;
            float rs = 0.f;
#pragma unroll
            for (int r = 0; r < 16; ++r) { p0[r] = __builtin_amdgcn_exp2f(p0[r] - mn); p1[r] = __builtin_amdgcn_exp2f(p1[r] - mn); rs += p0[r] + p1[r]; }
            lsum = lsum * corr + rs;
            if (__any(corr != 1.0f)) {
#pragma unroll
                for (int r = 0; r < 16; ++r) { o0[r] *= corr; o1[r] *= corr; }
            }
            seen = true;
            const LAS unsigned char* vb = lds + VOFF + buf * VSZ + r32 * 136 + 8 * hi;
#pragma unroll
            for (int s4 = 0; s4 < 4; ++s4) {
                v4u pw;
                if (s4 == 0) { pw.x = pk2(p0[0], p0[1]); pw.y = pk2(p0[2], p0[3]); pw.z = pk2(p0[4], p0[5]); pw.w = pk2(p0[6], p0[7]); }
                if (s4 == 1) { pw.x = pk2(p0[8], p0[9]); pw.y = pk2(p0[10], p0[11]); pw.z = pk2(p0[12], p0[13]); pw.w = pk2(p0[14], p0[15]); }
                if (s4 == 2) { pw.x = pk2(p1[0], p1[1]); pw.y = pk2(p1[2], p1[3]); pw.z = pk2(p1[4], p1[5]); pw.w = pk2(p1[6], p1[7]); }
                if (s4 == 3) { pw.x = pk2(p1[8], p1[9]); pw.y = pk2(p1[10], p1[11]); pw.z = pk2(p1[12], p1[13]); pw.w = pk2(p1[14], p1[15]); }
                const v8s pf = __builtin_bit_cast(v8s, pw);
                const v2u a0 = *(const LAS v2u*)(vb + 32 * s4), a1 = *(const LAS v2u*)(vb + 32 * s4 + 16);
                const v2u c0 = *(const LAS v2u*)(vb + 32 * 136 + 32 * s4), c1 = *(const LAS v2u*)(vb + 32 * 136 + 32 * s4 + 16);
                const v4u va = {a0.x, a0.y, a1.x, a1.y}, vc2 = {c0.x, c0.y, c1.x, c1.y};
                o0 = MFMA32(__builtin_bit_cast(v8s, va), pf, o0);
                o1 = MFMA32(__builtin_bit_cast(v8s, vc2), pf, o1);
            }
        }
        if (more) ATT_STORE(buf ^ 1);
        if (REV) {
            int vote = 0;
            if (seen && kt > 0) { const float fb0 = ((const LAS float*)(lds + FOFF + buf * 256))[0]; const float kb = MS[32 + ((kt - 1) >> 1)]; vote = __all((qn * kb + fb0 - m) < -40.0f) ? 1 : 0; }
            volatile LAS int* vt = (volatile LAS int*)(MS + 64) + (it & 1) * 8;
            if (lane == 0) vt[wave] = vote;
            __syncthreads();
            const int stop = vt[0] & vt[1] & vt[2] & vt[3] & vt[4] & vt[5] & vt[6] & vt[7];
            if (stop) break;
        } else {
            __syncthreads();
        }
        buf ^= 1;
    }
#undef ATT_LOAD
#undef ATT_STORE
    lsum += __shfl_xor(lsum, 32);
    const float inv = 1.0f / lsum;
    float sq = 0.f;
#pragma unroll
    for (int r = 0; r < 16; ++r) { o0[r] *= inv; o1[r] *= inv; sq += o0[r] * o0[r] + o1[r] * o1[r]; }
    sq += __shfl_xor(sq, 32);
    if (hi == 0) ssq[(rowbase + q) * 16] = sq;
    {
        LAS unsigned char* stg = lds + 65536 + wave * 4608;
#pragma unroll
        for (int g = 0; g < 4; ++g) {
            v2u w; w.x = pk2(o0[4 * g], o0[4 * g + 1]); w.y = pk2(o0[4 * g + 2], o0[4 * g + 3]); *(LAS v2u*)(stg + r32 * 136 + (8 * g + 4 * hi) * 2) = w;
            v2u x; x.x = pk2(o1[4 * g], o1[4 * g + 1]); x.y = pk2(o1[4 * g + 2], o1[4 * g + 3]); *(LAS v2u*)(stg + r32 * 136 + (32 + 8 * g + 4 * hi) * 2) = x;
        }
        asm volatile("s_waitcnt lgkmcnt(0)" ::: "memory");
        bf16* ow = O + (rowbase + qw0) * 1024;
#pragma unroll
        for (int i = 0; i < 4; ++i) {
            const int row = i * 8 + (lane >> 3), ch = lane & 7;
            const v2u lo = *(const LAS v2u*)(stg + row * 136 + ch * 16), hi2 = *(const LAS v2u*)(stg + row * 136 + ch * 16 + 8);
            *(v4u*)(ow + (size_t)row * 1024 + ch * 8) = (v4u){lo.x, lo.y, hi2.x, hi2.y};
        }
    }
}

DI void attn_slot(AP a, int l, int v, LAS unsigned char* lds, int tid, int lane, int wave) {
    unsigned char* ws = a->ws;
    const bf16* proj = (const bf16*)(ws + WS_PROJ);
    const bf16* qm = (const bf16*)(ws + WS_QM); const bf16* km = (const bf16*)(ws + WS_KM);
    const bf16* vts = (const bf16*)(ws + WS_VTS); const bf16* vtf = (const bf16*)(ws + WS_VTF); const bf16* vtm = (const bf16*)(ws + WS_VTM);
    bf16* mix = (bf16*)(ws + WS_MIX); float* ssqg = (float*)(ws + WS_SSQG);
    const float* floc = (const float*)(ws + WS_FLOC); const float* ftot = (const float*)(ws + WS_FTOT);
    const float* btab = (const float*)(ws + WS_BTAB);
    const int bh = v >> 3, s = v & 7, b = bh >> 2, h = bh & 3;
#pragma unroll 1
    for (int i = 0; i < 2; ++i) {
        const int qb = i == 0 ? 15 - s : s;
        attn_unit<2>(b, qb, qm + 96 * h, 384, km + 96 * h, 384, vtm + (size_t)(b * 4 + h) * 64 * SEQ, mix + 768 + 64 * h, ssqg + 12 + h, nullptr, nullptr, nullptr, 0, lds, tid, lane, wave);
    }
#pragma unroll 1
    for (int i = 0; i < 2; ++i) {
        const int qb = i == 0 ? 15 - s : s;
        attn_unit<1>(b, qb, proj + C_FOXQ + 64 * h, NPROJ, proj + C_FOXK + 64 * h, NPROJ, vtf + (size_t)(b * 4 + h) * 64 * SEQ, mix + 512 + 64 * h, ssqg + 8 + h,
                     floc + h, ftot + (size_t)(b * 32) * 4 + h, (const float*)(ws + WS_KNMAX) + (size_t)(b * 32) * 4 + h, 4, lds, tid, lane, wave);
    }
#pragma unroll 1
    for (int i = 0; i < 4; ++i) {
        const int u = 4 * v + i, qb = u & 15, hq = (u >> 4) & 7, bb = u >> 7, kvh = hq >> 2;
        attn_unit<0>(bb, qb, proj + C_SWAQ + 64 * hq, NPROJ, proj + C_SWAK + 64 * kvh, NPROJ, vts + (size_t)(bb * 2 + kvh) * 64 * SEQ, mix + 64 * hq, ssqg + hq,
                     btab + hq * 128, a->in[I_SINK] + l * 8 + hq, nullptr, 0, lds, tid, lane, wave);
    }
}

DI void fixup_phase(AP a, int l, int gtid, int gthreads) {
    unsigned char* ws = a->ws;
    const float* gside = (const float*)(ws + WS_GSIDE); const float* cwp = (const float*)(ws + WS_CWP) + (size_t)l * 4 * NUP;
    bf16* A = (bf16*)(ws + WS_A);
    for (int it = gtid; it < 120 * 2 * 22 * 32; it += gthreads) {
        const int jj4 = it & 31, rest = it >> 5, pn = rest % 22, r2 = rest / 22, r = r2 & 1, tile = r2 >> 1;
        const int pm = (tile / 15) * 16 + 1 + tile % 15;
        float cv[2][4];
#pragma unroll
        for (int bj = 0; bj < 2; ++bj) {
            const int nidx = 256 * pn + 128 * bj + 4 * jj4;
            const v4f g0 = *(const v4f*)(gside + (size_t)(pm * 4 + r) * NUP + nidx);
            const v4f g1 = *(const v4f*)(gside + (size_t)(r == 1 ? pm * 4 + 0 : (pm - 1) * 4 + 3) * NUP + nidx);
            const v4f g2 = *(const v4f*)(gside + (size_t)(r == 1 ? (pm - 1) * 4 + 3 : (pm - 1) * 4 + 2) * NUP + nidx);
            const v4f w0 = *(const v4f*)(cwp + nidx), w1 = *(const v4f*)(cwp + NUP + nidx), w2 = *(const v4f*)(cwp + 2 * NUP + nidx), cb = *(const v4f*)(cwp + 3 * NUP + nidx);
#pragma unroll
            for (int i = 0; i < 4; ++i) cv[bj][i] = cb[i] + w0[i] * g2[i] + w1[i] * g1[i] + w2[i] * g0[i];
        }
        v2u w; w.x = pk2(gelu_tanh(cv[0][0]) * cv[1][0], gelu_tanh(cv[0][1]) * cv[1][1]); w.y = pk2(gelu_tanh(cv[0][2]) * cv[1][2], gelu_tanh(cv[0][3]) * cv[1][3]);
        *(v2u*)(A + (size_t)(256 * pm + r) * DFF + 128 * pn + 4 * jj4) = w;
    }
}

DI void fixup_panel(AP a, int l, int pm, int tid) {
    unsigned char* ws = a->ws;
    const float* gside = (const float*)(ws + WS_GSIDE); const float* cwp = (const float*)(ws + WS_CWP) + (size_t)l * 4 * NUP;
    for (int it = tid; it < 2 * 22 * 32; it += 512) {
        const int jj4 = it & 31, rest = it >> 5, pn = rest % 22, r = rest / 22;
        float cv[2][4];
#pragma unroll
        for (int bj = 0; bj < 2; ++bj) {
            const int nidx = 256 * pn + 128 * bj + 4 * jj4;
            const v4f g0 = *(const v4f*)(gside + (size_t)(pm * 4 + r) * NUP + nidx);
            const v4f g1 = *(const v4f*)(gside + (size_t)(r == 1 ? pm * 4 + 0 : (pm - 1) * 4 + 3) * NUP + nidx);
            const v4f g2 = *(const v4f*)(gside + (size_t)(r == 1 ? (pm - 1) * 4 + 3 : (pm - 1) * 4 + 2) * NUP + nidx);
            const v4f w0 = *(const v4f*)(cwp + nidx), w1 = *(const v4f*)(cwp + NUP + nidx), w2 = *(const v4f*)(cwp + 2 * NUP + nidx), cb = *(const v4f*)(cwp + 3 * NUP + nidx);
#pragma unroll
            for (int i = 0; i < 4; ++i) cv[bj][i] = cb[i] + w0[i] * g2[i] + w1[i] * g1[i] + w2[i] * g0[i];
        }
        v2u w; w.x = pk2(gelu_tanh(cv[0][0]) * cv[1][0], gelu_tanh(cv[0][1]) * cv[1][1]); w.y = pk2(gelu_tanh(cv[0][2]) * cv[1][2], gelu_tanh(cv[0][3]) * cv[1][3]);
        *(v2u*)(a_row(ws, 256 * pm + r) + 128 * pn + 4 * jj4) = w;
    }
}

DI void cvt_layers(AP a, LAS unsigned char* lds, int lane, int wave, int gw, int NGW, int l0, int nl) {
    unsigned char* ws = a->ws;
    LAS float* scr = (LAS float*)(lds + wave * 16384);
    constexpr int I_IN = 16 * 64, I_UQ = 4 * 12, I_UKV = 2 * 16, I_OUT = 16 * 32, I_UP = 16 * 176, I_DOWN = 44 * 32, I_LAYER = I_IN + I_UQ + I_UKV + I_OUT + I_UP + I_DOWN;
    for (int it = gw; it < nl * I_LAYER; it += NGW) {
        const int l = l0 + it / I_LAYER; int r = it % I_LAYER;
        unsigned char* wl = ws + WS_W + (size_t)l * W_LAYER;
        if (r < I_IN) { cvt_item<1>(a->in[I_WIN] + (size_t)l * 1024 * IN_COLS, 1024, IN_COLS, (bf16*)(wl + WO_IN), NPROJ, a->in[I_APRE] + l * 1024, C64, scr, r, lane); continue; } r -= I_IN;
        if (r < I_UQ) { cvt_item<0>(a->in[I_WUQ] + (size_t)l * 256 * 384, 256, 384, (bf16*)(wl + WO_UQ), 384, a->in[I_QLN] + l * 256, C96, scr, r, lane); continue; } r -= I_UQ;
        if (r < I_UKV) { cvt_item<3>(a->in[I_WUKV] + (size_t)l * 128 * 512, 128, 512, (bf16*)(wl + WO_UKV), 512, a->in[I_KVLN] + l * 128, 1.f, scr, r, lane); continue; } r -= I_UKV;
        if (r < I_OUT) { cvt_item<0>(a->in[I_WOUT] + (size_t)l * 1024 * 1024, 1024, 1024, (bf16*)(wl + WO_OUT), 1024, a->in[I_GN] + l * 1024, 1.f, scr, r, lane); continue; } r -= I_OUT;
        if (r < I_UP) { cvt_item<2>(a->in[I_WUP] + (size_t)l * 1024 * NUP, 1024, NUP, (bf16*)(wl + WO_UP), NUP, a->in[I_FPRE] + l * 1024, 1.f, scr, r, lane); continue; } r -= I_UP;
        cvt_item<0>(a->in[I_WDOWN] + (size_t)l * DFF * 1024, DFF, 1024, (bf16*)(wl + WO_DOWN), 1024, nullptr, 1.f, scr, r, lane);
    }
}

DI void prologue(AP a, LAS unsigned char* lds, int tid, int lane, int wave, int vcu, int G) {
    unsigned char* ws = a->ws;
    LAS float* scr = (LAS float*)(lds + wave * 16384);
    const int gw = vcu * 8 + wave, NGW = G * 8;
    cvt_layers(a, lds, lane, wave, gw, NGW, 0, 1);
    const int gtid = gw * 64 + lane, gth = NGW * 64;
    { float* rope = (float*)(ws + WS_ROPE);
      for (int i = gtid; i < SEQ * 16; i += gth) {
          const int pos = i >> 4, k = i & 15;
          const float inv = exp2f(-(float)k * (2.0f / 32.0f) * 13.287712379549449f);
          const float ang = (float)pos * inv;
          const float n = rintf(ang * 0.15915494309189535f);
          float rr = fmaf(-n, 6.28318548202514648f, ang); rr = fmaf(-n, -1.7484555e-7f, rr);
          rope[pos * 32 + k] = cosf(rr); rope[pos * 32 + 16 + k] = sinf(rr);
      } }
    { float* bt = (float*)(ws + WS_BTAB);
      for (int i = gtid; i < 8 * 128; i += gth) {
          const int h = i >> 7, d = i & 127; int bk = d;
          if (d >= 16) { bk = 16 + (int)(__log2f((float)d * (1.0f / 16.0f)) * (16.0f / 3.0f)); bk = bk > 31 ? 31 : bk; }
          bt[i] = a->in[I_RELB][bk * 8 + h] * LOG2E;
      } }
    { float* cwp = (float*)(ws + WS_CWP);
      for (int i = gtid; i < DEPTH * 4 * NUP; i += gth) {
          const int n = i % NUP, q = (i / NUP) & 3, l = i / (4 * NUP), sc = srccol<2>(n);
          cwp[i] = q < 3 ? a->in[I_CW][((size_t)l * 3 + q) * NUP + sc] : a->in[I_CB][(size_t)l * NUP + sc];
      } }
#pragma unroll 4
    for (int mrow = gw; mrow < T; mrow += NGW) {
        const v4f* src = (const v4f*)(a->in[I_X] + (size_t)mrow * 1024) + lane; v2u* hp = (v2u*)((bf16*)(ws + WS_HB) + (size_t)mrow * 1024) + lane;
        float s = 0.f;
#pragma unroll
        for (int j = 0; j < 4; ++j) { const v4f v = src[64 * j]; s += (v[0] * v[0] + v[1] * v[1]) + (v[2] * v[2] + v[3] * v[3]); v2u w; w.x = pk2(v[0], v[1]); w.y = pk2(v[2], v[3]); hp[64 * j] = w; }
        s = wave_sum(s);
        if (lane < 16) ((float*)(ws + WS_SLOT2))[(size_t)mrow * 16 + lane] = (lane == 0) ? s : 0.f;
    }
}

constexpr int NSP = 6, NPHASE = 1 + NSP * DEPTH;
#ifndef MK_PHM
#define MK_PHM 1023u
#endif
constexpr unsigned PHM = MK_PHM;
#ifndef MK_DUP
#define MK_DUP 0u
#endif
constexpr unsigned DUPM = MK_DUP;
__global__ void __launch_bounds__(512, 2) trunk_fwd(Args a_) {
    extern __shared__ __attribute__((aligned(16))) unsigned char lds_raw[];
    LAS unsigned char* lds = (LAS unsigned char*)lds_raw;
    cg::grid_group grid = cg::this_grid();
    const int tid0 = threadIdx.x, wave0 = __builtin_amdgcn_readfirstlane(tid0 >> 6);
    XcdBarrier bar; bar.bar = nullptr; bar.x = 0; bar.st = nullptr;
    if (a_.coop) {
        volatile LAS unsigned* misc = (volatile LAS unsigned*)(lds + MISC_OFF);
        if (tid0 < 16) misc[tid0] = 0u;
        __syncthreads();
        bar = xcd_barrier_post((unsigned*)(a_.ws + WS_CTL), misc + 8, tid0);
        if (tid0 == 0) {
            unsigned* fl = (unsigned*)(a_.ws + WS_CTL + CTL_FLAG_OFF); const unsigned g = blockIdx.x & 7u, xc = xb_xcc_id();
            atomicMax(fl + g, xc + 1u); atomicMax(fl + 8 + g, 16u - xc);
            if (gridDim.x != 256u) atomicOr(fl + 16, 1u);
        }
    }
    const int ph_lo = a_.ph_lo, ph_hi = a_.ph_hi, coop = a_.coop;
    bool fastseam = false; unsigned gepoch = 0u;
    for (int ph = ph_lo; ph < ph_hi; ++ph) {
        const int spx = ph == 0 ? 9 : (ph - 1) % NSP;
        for (int rep = 0; rep < (((DUPM >> spx) & 1u) ? 2 : 1); ++rep) {
        if (rep > 0 && coop) xcd_barrier(bar, wave0 * 64 + hw_lane());
        AP a = (AP)__builtin_amdgcn_kernarg_segment_ptr(); asm volatile("" : "+s"(a));
#define PH_TID() const int tid = wave0 * 64 + hw_lane(), lane = tid & 63, wave = wave0
        int G = gridDim.x, bx = blockIdx.x; asm volatile("" : "+s"(G), "+s"(bx));
        const int vcu = (G % 8 == 0) ? (bx % 8) * (G / 8) + bx / 8 : bx;
        unsigned char* ws = a->ws;
        if (ph == 0) {
            if (PHM & 512u) { PH_TID(); prologue(a, lds, tid, lane, wave, vcu, G); }
        } else {
            const int l = (ph - 1) / NSP, sp = (ph - 1) % NSP;
            unsigned char* wl = ws + WS_W + (size_t)l * W_LAYER;
            if (sp == 0 && (PHM & 1u)) {
                pg8::Gemm g{(const bf16*)(ws + WS_HB), (const bf16*)(wl + WO_IN), T, NPROJ, 1024}; pg8::StaticOrder S; S.init(T, NPROJ, G, bx);
                { PH_TID(); (void)lane; (void)wave; row_scales(S, (const float*)(ws + WS_SLOT2), (float*)(ws + WS_RSTDX), tid); }
                EpiProj E{(bf16*)(ws + WS_PROJ), (const float*)(ws + WS_RSTDX)};
                pg8::gemm_phase<EpiProj, pg8::StaticOrder, true, true>(lds, g, S, E, wave0 * 64 + hw_lane());
            } else if (sp == 1 && (PHM & 2u)) {
                PH_TID();
                if (l == 0) { cvt_layers(a, lds, lane, wave, vcu * 8 + wave, G * 8, 1, DEPTH - 1); __syncthreads(); }
                for (int u = vcu; u < T / 128; u += G) prep_unit(a, l, u, lds, tid, lane, wave);
            } else if (sp == 2 && (PHM & 4u)) {
                PH_TID(); for (int v = vcu; v < 256; v += G) attn_slot(a, l, v, lds, tid, lane, wave);
            } else if (sp == 3 && (PHM & 8u)) {
                pg8::Gemm g{(const bf16*)(ws + WS_MIX), (const bf16*)(wl + WO_OUT), T, 1024, 1024}; pg8::StaticOrder S; S.init(T, 1024, G, bx);
                pg8::Unit u0{-1, -1}, u1{-1, -1};
                { PH_TID(); (void)lane; (void)wave; const float* sg = (const float*)(ws + WS_SSQG);
                  if (S.next(0, u0)) seam_factors(sg, u0.pm, (LAS float*)(lds + HALO_OFF), tid);
                  if (S.next(1, u1)) seam_factors(sg, u1.pm, (LAS float*)(lds + HALO_OFF) + 768, tid);
                  __syncthreads(); }
                EpiRes<true> E{a, l, lds + HALO_OFF, u0.pm, u0.pn, fastseam};
                pg8::gemm_phase<EpiRes<true>, pg8::StaticOrder, true, true>(lds, g, S, E, wave0 * 64 + hw_lane());
            } else if (sp == 4 && (PHM & 32u)) {
                pg8::Gemm g{(const bf16*)(ws + WS_HB), (const bf16*)(wl + WO_UP), T, NUP, 1024}; pg8::StaticOrder S; S.init(T, NUP, G, bx);
                { PH_TID(); (void)lane; (void)wave; row_scales(S, (const float*)(ws + WS_SLOT2), (float*)(ws + WS_RSTDX), tid); }
                EpiConv E{ws, (const float*)(ws + WS_CWP) + (size_t)l * 4 * NUP, (float*)(ws + WS_GSIDE), lds + HALO_OFF, (const float*)(ws + WS_RSTDX)};
                pg8::gemm_phase<EpiConv, pg8::StaticOrder, true, true>(lds, g, S, E, wave0 * 64 + hw_lane());
            } else if (sp == 5 && (PHM & 128u)) {
                pg8::Gemm g{(const bf16*)(ws + WS_PROJ), (const bf16*)(wl + WO_DOWN), T, 1024, DFF, (const char*)(ws + WS_MIX)}; pg8::StaticOrder S; S.init(T, 1024, G, bx);
                { PH_TID(); (void)lane; (void)wave; pg8::Unit u;
                  for (int i = 0; S.next(i, u); ++i) if ((u.pm & 15) != 0) fixup_panel(a, l, u.pm, tid);
                  asm volatile("s_waitcnt vmcnt(0)" ::: "memory"); __syncthreads(); }
                EpiRes<false> E{a, l, lds + HALO_OFF, 0, 0, fastseam};
                pg8::gemm_phase<EpiRes<false>, pg8::StaticOrder, true, true>(lds, g, S, E, wave0 * 64 + hw_lane());
            }
        }
        }
        if (ph + 1 < ph_hi && coop && ph == 0) { grid.sync(); { const unsigned* fl = (const unsigned*)(a_.ws + WS_CTL + CTL_FLAG_OFF); bool ok = __hip_atomic_load(fl + 16, __ATOMIC_RELAXED, __HIP_MEMORY_SCOPE_AGENT) == 0u;
            for (int g = 0; g < 8; ++g) { const unsigned mx = __hip_atomic_load(fl + g, __ATOMIC_RELAXED, __HIP_MEMORY_SCOPE_AGENT), mi = __hip_atomic_load(fl + 8 + g, __ATOMIC_RELAXED, __HIP_MEMORY_SCOPE_AGENT); ok = ok && (mx + mi == 17u); }
            fastseam = ok; } }
        else if (ph + 1 < ph_hi && coop && fastseam && ph != 2) {        xcd_local_barrier((unsigned*)(a_.ws + WS_CTL + CTL_GRP_OFF) + 64 * (blockIdx.x & 7u), gepoch, wave0 * 64 + hw_lane()); ++gepoch; }
        else if (ph + 1 < ph_hi) { if (coop) { if (ph == 0) grid.sync(); else xcd_barrier(bar, wave0 * 64 + hw_lane()); if (DUPM & 1024u) xcd_barrier(bar, wave0 * 64 + hw_lane()); } }
    }
}

#ifndef MK_COOP
#define MK_COOP 0
#endif
extern "C" void kernel_launch(void* const* d_in, const int* in_sizes, int n_in, void* d_out, int out_size, void* d_ws, size_t ws_size, hipStream_t stream) {
    static int grid = 0;
    if (grid == 0) {
        if (n_in != 19 || out_size != T * 1024 || ws_size < WS_END) { fprintf(stderr, "kernel_launch: unexpected shapes (n_in %d out %d ws %zu)\n", n_in, out_size, ws_size); grid = -1; return; }
        int dev = 0, cus = 0, per_cu = 0;
        hipGetDevice(&dev); hipDeviceGetAttribute(&cus, hipDeviceAttributeMultiprocessorCount, dev);
        hipFuncSetAttribute((const void*)trunk_fwd, hipFuncAttributeMaxDynamicSharedMemorySize, LDS_BYTES);
        hipOccupancyMaxActiveBlocksPerMultiprocessor(&per_cu, (const void*)trunk_fwd, 512, LDS_BYTES);
        if (per_cu < 1) { fprintf(stderr, "kernel_launch: occupancy query says %d blocks/CU\n", per_cu); per_cu = 1; }
        (void)hipGetLastError();
        grid = cus * per_cu;
        fprintf(stderr, "kernel_launch: grid %d (cus %d x %d)\n", grid, cus, per_cu);
    }
    if (grid < 0) return;
    Args a{};
    for (int i = 0; i < 19; ++i) a.in[i] = (const float*)d_in[i];
    a.out = (float*)d_out; a.ws = (unsigned char*)d_ws; a.pad = 0;
#if MK_COOP
    if (hipMemsetAsync((char*)d_ws + WS_CTL, 0, CTL_BYTES, stream) != hipSuccess) { fprintf(stderr, "kernel_launch: memset of barrier words failed\n"); return; }
    a.ph_lo = 0; a.ph_hi = NPHASE; a.coop = 1;
    void* args[] = {&a};
    hipError_t e = hipLaunchCooperativeKernel((const void*)trunk_fwd, dim3(grid), dim3(512), args, LDS_BYTES, stream);
    if (e != hipSuccess) fprintf(stderr, "cooperative launch failed: %s (grid %d)\n", hipGetErrorString(e), grid);
#else
    a.coop = 0;
    for (int ph = 0; ph < NPHASE; ++ph) {
        a.ph_lo = ph; a.ph_hi = ph + 1;
        hipLaunchKernelGGL(trunk_fwd, dim3(grid), dim3(512), LDS_BYTES, stream, a);
    }
#endif
}
```

```cpp
#include <hip/hip_runtime.h>
#include <hip/hip_cooperative_groups.h>
#include <cstdio>
#include <cstdint>
namespace cg = cooperative_groups;
#define MK_COOP 1
namespace pg8 {
#define PG8_LAS __attribute__((address_space(3)))
typedef unsigned short bf16_t;
typedef short bf16x8 __attribute__((ext_vector_type(8)));
typedef float f32x4 __attribute__((ext_vector_type(4)));
typedef unsigned u32x4 __attribute__((ext_vector_type(4)));
constexpr int BM = 256, BK = 64, HALF = 128, HTB = HALF * BK * 2  , STAGE_BYTES = 8 * HTB, NXCD = 8, WGM = 8;

__host__ __device__ __forceinline__ int lds_byte(int r, int c) { const int st = (r >> 4) * 2 + (c >> 5), rr = r & 15, cc = c & 31, ob = rr * 64 + cc * 2; return st * 1024 + (ob ^ (((ob >> 9) & 1) << 5)); }
__host__ __device__ __forceinline__ void stage_rc(int b, int& R, int& C) { const int st = b / 1024, sb = b % 1024, swz = sb ^ (((sb >> 9) & 1) << 5); R = (st >> 1) * 16 + swz / 64; C = (st & 1) * 32 + (swz % 64) / 2; }
__host__ __device__ __forceinline__ int perm32(int rho) { const int n = rho >> 4, i = rho & 15; return 8 * (i >> 2) + 4 * n + (i & 3); }

struct Unit { int pm, pn; };
struct Gemm { const bf16_t* A; const bf16_t* Bt; int M, N, K; const char* Asplit = nullptr;
    __device__ __forceinline__ const char* apanel(int pm, size_t tstep) const {
        if (!Asplit) return (const char*)A + (size_t)pm * tstep;
        const int gb = pm >> 4, j = pm & 15;
        return j < 11 ? (const char*)A + ((size_t)gb << 24) + (size_t)j * tstep : Asplit + ((size_t)gb << 23) + (size_t)(j - 11) * tstep;
    } };

struct StaticOrder {
    int nM, nN, nwg, G, c;
    __host__ __device__ void init(int M, int N, int G_, int c_) { nM = M / BM; nN = N / BM; nwg = nM * nN; G = G_; c = c_; }
    __host__ __device__ bool next(int i, Unit& u) const {
        const long L = (long)i * G + c; if (L >= nwg) return false;
        int wgid = (int)L; { const int q = nwg / NXCD, r = nwg % NXCD, xcd = wgid % NXCD, off = wgid / NXCD; wgid = (xcd < r ? xcd * (q + 1) : r * (q + 1) + (xcd - r) * q) + off; }
        const int nig = WGM * nN, gid = wgid / nig, fm = gid * WGM, gsz = (nM - fm) < WGM ? (nM - fm) : WGM;
        u.pm = fm + ((wgid % nig) % gsz); u.pn = (wgid % nig) / gsz; return true;
    }
    __device__ __forceinline__ void a_ready(const Unit&) const {}
    __device__ __forceinline__ void done(const Unit&) const {}
};

__device__ __forceinline__ unsigned cvt_pk_bf16(float lo, float hi) { unsigned r; asm volatile("v_cvt_pk_bf16_f32 %0, %1, %2" : "=v"(r) : "v"(lo), "v"(hi)); return r; }
typedef float f32x2 __attribute__((ext_vector_type(2)));
__device__ __forceinline__ f32x2 gelu_pk(f32x2 v) {
    const f32x2 av = __builtin_elementwise_abs(v), d = av * 0.2316418882f + 1.0f;
    f32x2 t; t.x = __builtin_amdgcn_rcpf(d.x); t.y = __builtin_amdgcn_rcpf(d.y);
    f32x2 q = t * 0.5307027145f + (-0.7265760135f); q = q * t + 0.7107068705f; q = q * t + (-0.142248368f); q = q * t + 0.127414796f; q = q * t;
    const f32x2 s = (v * v) * (-0.72134752044f);
    f32x2 e; e.x = __builtin_amdgcn_exp2f(s.x); e.y = __builtin_amdgcn_exp2f(s.y);
    const f32x2 m = v * (q * e), r = v - m;
    f32x2 o; o.x = v.x < 0.f ? m.x : r.x; o.y = v.y < 0.f ? m.y : r.y; return o;
}

template <int ACT  > struct EpiBf16 {
    static constexpr bool PERM = true, AFTER_DRAIN = false, KSEG = false; static_assert(ACT == 0 || ACT == 1, "EpiBf16: ACT is 0 (none) or 1 (gelu_pk)");
    bf16_t* O; int ldc; const float* bias; int split_cols; size_t split_stride; float scale0;
    __device__ __forceinline__ void operator()(const f32x4 (&acc)[2][2][4][2], const Unit& u, int wr, int wc, int fr, int fq) const {
        const int row0 = u.pm * BM + wr * 64 + fr; int colt = u.pn * BM; bf16_t* base = O;
        float sc = 1.f; if (split_cols) { const int t = colt / split_cols; base += (size_t)t * split_stride; colt -= t * split_cols; if (t == 0) sc = scale0; }
        const int col0 = colt + wc * 32 + 8 * fq, bcol0 = u.pn * BM + wc * 32 + 8 * fq;
        f32x4 bv[2][2];
#pragma unroll
        for (int bj = 0; bj < 2; ++bj)
#pragma unroll
            for (int n = 0; n < 2; ++n) bv[bj][n] = bias ? *(const f32x4*)(bias + bcol0 + bj * HALF + 4 * n) : (f32x4){0.f, 0.f, 0.f, 0.f};
#pragma unroll
        for (int ai = 0; ai < 2; ++ai)
#pragma unroll
            for (int m = 0; m < 4; ++m) { bf16_t* rowp = base + (size_t)(row0 + ai * HALF + m * 16) * ldc + col0;
#pragma unroll
                for (int bj = 0; bj < 2; ++bj) { f32x4 v0 = acc[ai][bj][m][0] + bv[bj][0], v1 = acc[ai][bj][m][1] + bv[bj][1];
                    if (ACT == 1) { f32x2 a = gelu_pk((f32x2){v0[0], v0[1]}), b = gelu_pk((f32x2){v0[2], v0[3]}), c = gelu_pk((f32x2){v1[0], v1[1]}), d = gelu_pk((f32x2){v1[2], v1[3]});
                        v0 = (f32x4){a.x, a.y, b.x, b.y}; v1 = (f32x4){c.x, c.y, d.x, d.y}; }
                    v0 = v0 * sc; v1 = v1 * sc; u32x4 w; w.x = cvt_pk_bf16(v0[0], v0[1]); w.y = cvt_pk_bf16(v0[2], v0[3]); w.z = cvt_pk_bf16(v1[0], v1[1]); w.w = cvt_pk_bf16(v1[2], v1[3]);
                    *(u32x4*)(rowp + bj * HALF) = w; } }
    }
};
template <class Epi, class Sched, bool ALIGN_EPI = false, bool SP2 = false>
__device__ __forceinline__ void gemm_phase(PG8_LAS unsigned char* lds, const Gemm g, const Sched& S, const Epi& E, int tid_in) {
    int tid_ = tid_in; asm volatile("" : "+v"(tid_));
    const int tid = tid_, wid = __builtin_amdgcn_readfirstlane(tid >> 6), lane = tid & 63, wr = wid >> 2, wc = wid & 3, fr = lane & 15, fq = lane >> 4;
    const int K = g.K, nt = K / BK;
    unsigned voffA[2], voffB[2];
#pragma unroll
    for (int i = 0; i < 2; ++i) { int R, C; stage_rc(tid * 16 + i * 8192, R, C); const int Rb = Epi::PERM ? ((R & ~31) + perm32(R & 31)) : R;
        voffA[i] = (unsigned)(R * K + C) * 2u; voffB[i] = (unsigned)(Rb * K + C) * 2u; }
    const size_t kstep = (size_t)(BK * 2);
    const size_t hstep = (size_t)HALF * K * 2;
    const size_t tstep = 2 * hstep;
    const unsigned ldsw = (unsigned)wid * 1024u;
    const int aoff = lds_byte(wr * 64 + fr, fq * 8), boff = lds_byte(wc * 32 + fr, fq * 8);
#define PG8_SA(b, h) (((b) * 2 + (h)) * HTB)
#define PG8_SB(b, h) ((4 + (b) * 2 + (h)) * HTB)
#define PG8_STAGE(bufoff, gbase, voff) do { _Pragma("unroll") for (int _i = 0; _i < 2; ++_i) \
        __builtin_amdgcn_global_load_lds((const unsigned*)((const char*)(gbase) + (voff)[_i]), (PG8_LAS unsigned*)(lds + (bufoff) + ldsw + _i * 8192), 16, 0, 0); } while (0)
#define PG8_LDA(dst, b, h) do { _Pragma("unroll") for (int m = 0; m < 4; ++m) _Pragma("unroll") for (int k = 0; k < 2; ++k) dst[m][k] = *(const PG8_LAS bf16x8*)(lds + PG8_SA(b, h) + aoff + m * 2048 + k * 1024); } while (0)
#define PG8_LDB(dst, b, h) do { _Pragma("unroll") for (int n = 0; n < 2; ++n) _Pragma("unroll") for (int k = 0; k < 2; ++k) dst[n][k] = *(const PG8_LAS bf16x8*)(lds + PG8_SB(b, h) + boff + n * 2048 + k * 1024); } while (0)
#define PG8_MMA(ai, bj, At, Bt) do { __builtin_amdgcn_s_setprio(1); _Pragma("unroll") for (int m = 0; m < 4; ++m) _Pragma("unroll") for (int n = 0; n < 2; ++n) _Pragma("unroll") for (int k = 0; k < 2; ++k) \
        acc[ai][bj][m][n] = __builtin_amdgcn_mfma_f32_16x16x32_bf16(Bt[n][k], At[m][k], acc[ai][bj][m][n], 0, 0, 0); __builtin_amdgcn_s_setprio(0); } while (0)
#define PG8_WAIT_V(n) asm volatile("s_waitcnt vmcnt(" #n ")" ::: "memory")
#define PG8_WAIT_L(n) asm volatile("s_waitcnt lgkmcnt(" #n ")" ::: "memory")
#define PG8_BAR __builtin_amdgcn_s_barrier()
#define PG8_SCHED __builtin_amdgcn_sched_barrier(0)
    Unit cur, nxt; int ui = 0;
    if (!S.next(0, cur)) return;
    f32x4 acc[2][2][4][2];
#pragma unroll
    for (int a = 0; a < 2; ++a)
#pragma unroll
        for (int b = 0; b < 2; ++b)
#pragma unroll
            for (int m = 0; m < 4; ++m)
#pragma unroll
                for (int n = 0; n < 2; ++n) acc[a][b][m][n] = (f32x4){0.f, 0.f, 0.f, 0.f};
    bf16x8 At[4][2], B0[2][2], B1[2][2];
    const char* cA = g.apanel(cur.pm, tstep); const char* cB = (const char*)g.Bt + (size_t)cur.pn * tstep;
    S.a_ready(cur);
    if constexpr (SP2) {
        PG8_STAGE(PG8_SB(0, 0), cB, voffB); PG8_STAGE(PG8_SB(0, 1), cB + hstep, voffB); PG8_STAGE(PG8_SA(0, 0), cA, voffA); PG8_STAGE(PG8_SA(0, 1), cA + hstep, voffA);
        if (wr == 1) PG8_BAR;
        PG8_WAIT_V(2); PG8_BAR;
        PG8_STAGE(PG8_SB(1, 0), cB + kstep, voffB); PG8_STAGE(PG8_SA(1, 0), cA + kstep, voffA); PG8_STAGE(PG8_SB(1, 1), cB + hstep + kstep, voffB);
        PG8_WAIT_V(6); PG8_BAR;
    } else {
        PG8_STAGE(PG8_SB(0, 0), cB, voffB); PG8_STAGE(PG8_SA(0, 0), cA, voffA); PG8_STAGE(PG8_SB(0, 1), cB + hstep, voffB); PG8_STAGE(PG8_SA(0, 1), cA + hstep, voffA);
        if (wr == 1) PG8_BAR;
        PG8_WAIT_V(4); PG8_BAR;
        PG8_STAGE(PG8_SB(1, 0), cB + kstep, voffB); PG8_STAGE(PG8_SA(1, 0), cA + kstep, voffA); PG8_STAGE(PG8_SB(1, 1), cB + hstep + kstep, voffB);
        PG8_WAIT_V(6); PG8_BAR;
    }
    for (;;) {
        const bool has_next = S.next(ui + 1, nxt);
        const char* nA = has_next ? g.apanel(nxt.pm, tstep) : cA; const char* nB = has_next ? (const char*)g.Bt + (size_t)nxt.pn * tstep : cB;
        for (int seg = 0; seg < (Epi::KSEG ? 3 : 1); ++seg) {
        if constexpr (Epi::KSEG) { if (seg > 0) E.kscale(acc, seg, cur, wr, fr); }
        const int tb_ = Epi::KSEG ? (seg == 0 ? 0 : (seg == 1 ? 8 : 12)) : 0, te_ = Epi::KSEG ? (seg == 0 ? 8 : (seg == 1 ? 12 : nt)) : nt;
#pragma unroll 1
        for (int t = tb_; t < te_; t += 2) {
            const bool last = (t == nt - 2);
            const char* a1 = cA + (size_t)(t + 1) * kstep;
            const char* a2 = last ? nA : cA + (size_t)(t + 2) * kstep; const char* b2 = last ? nB : cB + (size_t)(t + 2) * kstep;
            const char* a3 = a2 + kstep; const char* b3 = b2 + kstep;
            if (last && has_next) S.a_ready(nxt);
            if constexpr (SP2) {
            PG8_LDB(B0, 0, 0); PG8_LDB(B1, 0, 1); PG8_SCHED; PG8_LDA(At, 0, 0); PG8_STAGE(PG8_SA(1, 1), a1 + hstep, voffA);
            PG8_WAIT_V(8); PG8_WAIT_L(0); PG8_BAR; PG8_MMA(0, 0, At, B0); PG8_MMA(0, 1, At, B1); PG8_BAR; PG8_SCHED;
            PG8_LDA(At, 0, 1); PG8_STAGE(PG8_SB(0, 0), b2, voffB); PG8_STAGE(PG8_SB(0, 1), b2 + hstep, voffB); PG8_STAGE(PG8_SA(0, 0), a2, voffA);
            PG8_WAIT_V(8); PG8_WAIT_L(0); PG8_BAR; PG8_MMA(1, 0, At, B0); PG8_MMA(1, 1, At, B1); PG8_BAR; PG8_SCHED;
            PG8_LDB(B0, 1, 0); PG8_LDB(B1, 1, 1); PG8_SCHED; PG8_LDA(At, 1, 0); PG8_STAGE(PG8_SA(0, 1), a2 + hstep, voffA);
            PG8_WAIT_V(8); PG8_WAIT_L(0); PG8_BAR; PG8_MMA(0, 0, At, B0); PG8_MMA(0, 1, At, B1); PG8_BAR; PG8_SCHED;
            PG8_LDA(At, 1, 1); PG8_STAGE(PG8_SB(1, 0), b3, voffB); PG8_STAGE(PG8_SB(1, 1), b3 + hstep, voffB); PG8_STAGE(PG8_SA(1, 0), a3, voffA);
            PG8_WAIT_V(8); PG8_WAIT_L(0); PG8_BAR; PG8_MMA(1, 0, At, B0); PG8_MMA(1, 1, At, B1); PG8_BAR; PG8_SCHED;
            } else {
            PG8_LDB(B0, 0, 0); PG8_SCHED; PG8_LDA(At, 0, 0); PG8_STAGE(PG8_SA(1, 1), a1 + hstep, voffA);
            PG8_WAIT_L(8); PG8_BAR; PG8_WAIT_L(0); PG8_MMA(0, 0, At, B0); PG8_BAR; PG8_SCHED;
            PG8_LDB(B1, 0, 1); PG8_STAGE(PG8_SB(0, 0), b2, voffB);
            PG8_BAR; PG8_WAIT_L(0); PG8_MMA(0, 1, At, B1); PG8_BAR;
            PG8_LDA(At, 0, 1); PG8_STAGE(PG8_SA(0, 0), a2, voffA);
            PG8_BAR; PG8_WAIT_L(0); PG8_MMA(1, 0, At, B0); PG8_BAR; PG8_SCHED;
            PG8_STAGE(PG8_SB(0, 1), b2 + hstep, voffB);
            PG8_WAIT_V(6); PG8_BAR; PG8_MMA(1, 1, At, B1); PG8_BAR;
            PG8_LDB(B0, 1, 0); PG8_SCHED; PG8_LDA(At, 1, 0); PG8_STAGE(PG8_SA(0, 1), a2 + hstep, voffA);
            PG8_WAIT_L(8); PG8_BAR; PG8_WAIT_L(0); PG8_MMA(0, 0, At, B0); PG8_BAR; PG8_SCHED;
            PG8_LDB(B1, 1, 1); PG8_STAGE(PG8_SB(1, 0), b3, voffB);
            PG8_BAR; PG8_WAIT_L(0); PG8_MMA(0, 1, At, B1); PG8_BAR;
            PG8_LDA(At, 1, 1); PG8_STAGE(PG8_SA(1, 0), a3, voffA);
            PG8_BAR; PG8_WAIT_L(0); PG8_MMA(1, 0, At, B0); PG8_BAR; PG8_SCHED;
            PG8_STAGE(PG8_SB(1, 1), b3 + hstep, voffB);
            PG8_WAIT_V(6); PG8_BAR; PG8_MMA(1, 1, At, B1); PG8_BAR;
            }
        }
        }
        if constexpr (ALIGN_EPI) { if (wr == 0) PG8_BAR; }
        if constexpr (!Epi::AFTER_DRAIN) { E(acc, cur, wr, wc, fr, fq); S.done(cur); }
        if (!has_next) break;
#pragma unroll
        for (int a = 0; a < 2; ++a)
#pragma unroll
            for (int b = 0; b < 2; ++b)
#pragma unroll
                for (int m = 0; m < 4; ++m)
#pragma unroll
                    for (int n = 0; n < 2; ++n) acc[a][b][m][n] = (f32x4){0.f, 0.f, 0.f, 0.f};
        cur = nxt; cA = nA; cB = nB; ++ui;
        if constexpr (ALIGN_EPI) { if (wr == 1) PG8_BAR; }
    }
    PG8_WAIT_V(0);
    if constexpr (!ALIGN_EPI) { if (wr == 0) PG8_BAR; }
    PG8_BAR;
    if constexpr (Epi::AFTER_DRAIN) { E.fused(acc, cur, wr, wc, fr, fq, lds, wid, lane); S.done(cur); }
#undef PG8_SA
#undef PG8_SB
#undef PG8_STAGE
#undef PG8_LDA
#undef PG8_LDB
#undef PG8_MMA
#undef PG8_WAIT_V
#undef PG8_WAIT_L
#undef PG8_BAR
#undef PG8_SCHED
}
}

#define DI __device__ __forceinline__
#define LAS __attribute__((address_space(3)))
typedef unsigned short bf16;
typedef short v8s __attribute__((ext_vector_type(8)));
typedef float v4f __attribute__((ext_vector_type(4)));
typedef float v16f __attribute__((ext_vector_type(16)));
typedef unsigned v4u __attribute__((ext_vector_type(4)));
typedef unsigned v2u __attribute__((ext_vector_type(2)));
typedef float f32x2_t __attribute__((ext_vector_type(2)));
typedef __bf16 bf16x2_t __attribute__((ext_vector_type(2)));

constexpr int BATCH = 8, SEQ = 4096, DMODEL = 1024, DEPTH = 4, T = BATCH * SEQ;
constexpr int NPROJ = 2048;
constexpr int C_SWAQ = 0, C_SWAK = 512, C_SWAV = 640, C_FOXQ = 768, C_FOXK = 1024, C_FOXV = 1280, C_CQ = 1536, C_CKV = 1792, C_KR = 1920, C_FL = 1952;
constexpr int DFF = 2816, NUP = 5632, IN_COLS = 1956;
constexpr float LOG2E = 1.4426950408889634f;
constexpr float C64 = 0.125f * LOG2E;
constexpr float C96 = 0.10206207261596575f * LOG2E;
constexpr float EPS = 1e-6f;
constexpr float NEGBIG = -1e30f;

constexpr size_t MiB = 1u << 20;
constexpr size_t WS_ROPE = 0, WS_BTAB = MiB / 2, WS_CWP = 1 * MiB, WS_RSTDX = MiB + MiB / 2, WS_SSQY = 16 * MiB, WS_SSQG = 18 * MiB, WS_FLOC = 3 * MiB, WS_FTOT = 3 * MiB + MiB / 2, WS_KNMAX = 3 * MiB + MiB / 2 + 65536, WS_GSIDE = 4 * MiB;
constexpr size_t WS_W = 20 * MiB, W_LAYER = 23 * MiB, WO_IN = 0, WO_OUT = 4 * MiB, WO_UP = 6 * MiB, WO_DOWN = 17 * MiB, WO_UQ = 22 * MiB + MiB / 2, WO_UKV = 22 * MiB + 3 * (MiB / 4);
constexpr size_t WS_HB = 112 * MiB, WS_R1 = 176 * MiB;
constexpr size_t WS_PROJ = WS_R1, WS_QM = WS_R1 + 128 * MiB, WS_KM = WS_R1 + 152 * MiB, WS_VTS = WS_R1 + 176 * MiB, WS_VTF = WS_R1 + 184 * MiB, WS_VTM = WS_R1 + 200 * MiB;
constexpr size_t WS_A = WS_R1, WS_Y1 = WS_R1;
constexpr size_t WS_MIX = 392 * MiB, WS_Y2 = WS_MIX, WS_CTL = 456 * MiB, CTL_BYTES = 16384 + 4 * 2 * 2 * 128 * 256 + 4096, CTL_CNT_OFF = 16384, CTL_GRP_OFF = 16384 + 4 * 2 * 2 * 128 * 256, CTL_FLAG_OFF = 15872, WS_SLOT2 = 457 * MiB, WS_END = 459 * MiB;

constexpr int RING_BYTES = 131072, HALO_OFF = RING_BYTES + 1024, LDS_BYTES = 147456, MISC_OFF = LDS_BYTES - 256;

DI unsigned pk2(float lo, float hi) { f32x2_t v = {lo, hi}; bf16x2_t b = __builtin_convertvector(v, bf16x2_t); return __builtin_bit_cast(unsigned, b); }
DI float bf2f(unsigned short u) { return __uint_as_float((unsigned)u << 16); }
DI float bflo(unsigned u) { return __uint_as_float(u << 16); }
DI float bfhi(unsigned u) { return __uint_as_float(u & 0xffff0000u); }
DI float max3f(float a, float b, float c) { float r; asm("v_max3_f32 %0, %1, %2, %3" : "=v"(r) : "v"(a), "v"(b), "v"(c)); return r; }
DI float max2f(float a, float b) { float r; asm("v_max_f32_e32 %0, %1, %2" : "=v"(r) : "v"(a), "v"(b)); return r; }
DI float fma_s(float a, float b, float c) { float r; asm("v_fma_f32 %0, %1, %2, %3" : "=v"(r) : "v"(a), "v"(b), "v"(c)); return r; }
DI int crow(int r, int hi) { return (r & 3) + 8 * (r >> 2) + 4 * hi; }
DI int hw_lane() { int l; asm volatile("v_mbcnt_lo_u32_b32 %0, -1, 0\n\tv_mbcnt_hi_u32_b32 %0, -1, %0" : "=v"(l)); return l; }
DI float wave_sum(float v) {
#pragma unroll
    for (int o = 1; o < 64; o <<= 1) v += __shfl_xor(v, o);
    return v;
}
DI float gelu_tanh(float x) {
    constexpr float C1 = -2.0f * 0.7978845608028654f * LOG2E, C2 = C1 * 0.044715f;
    const float e = __builtin_amdgcn_exp2f(x * __builtin_fmaf(x * x, C2, C1));
    return x * __builtin_amdgcn_rcpf(1.0f + e);
}
template <int CTRL> DI float dppf(float v) { return __int_as_float(__builtin_amdgcn_mov_dpp(__float_as_int(v), CTRL, 0xf, 0xf, true)); }

__device__ __forceinline__ void xcd_local_barrier(unsigned* ctr, unsigned epoch, int xtid) {
    asm volatile("s_waitcnt vmcnt(0)" ::: "memory");
    __syncthreads();
    if (xtid == 0) {
        __builtin_amdgcn_s_waitcnt(0);
        const unsigned target = (epoch + 1u) * 32u;
        (void)__hip_atomic_fetch_add(ctr, 1u, __ATOMIC_RELAXED, __HIP_MEMORY_SCOPE_AGENT);
        unsigned sp = 0u;
        while (__hip_atomic_load(ctr, __ATOMIC_RELAXED, __HIP_MEMORY_SCOPE_AGENT) < target) { __builtin_amdgcn_s_sleep(1); if (++sp > (1u << 22)) break; }
        __builtin_amdgcn_fence(__ATOMIC_ACQUIRE, "agent");
        asm volatile("s_waitcnt vmcnt(0)" ::: "memory");
    }
    __syncthreads();
}

struct Args { const float* in[19]; float* out; unsigned char* ws; int ph_lo, ph_hi, coop, pad; };
typedef const __attribute__((address_space(4))) Args* AP;
enum { I_X = 0, I_APRE, I_WIN, I_FB, I_SINK, I_RELB, I_QLN, I_WUQ, I_KVLN, I_WUKV, I_GN, I_WOUT, I_APOST, I_FPRE, I_WUP, I_CW, I_CB, I_WDOWN, I_FPOST };


template <bool KSEG_> struct EpiY {
    static constexpr bool PERM = true, AFTER_DRAIN = false, KSEG = KSEG_;
    bf16* Y; float* ssq; const float* ssqg; LAS unsigned char* fsl;
    DI void kprep(const pg8::Unit& u, int wid, int wr, int fr, int fq) const {
        LAS float* F = (LAS float*)fsl + wid * 384;
#pragma unroll
        for (int j = 0; j < 2; ++j) {
            const int idx = 2 * fq + j, ai = idx >> 2, m = idx & 3;
            const int row = u.pm * 256 + ai * 128 + wr * 64 + m * 16 + fr;
            const v4f s0 = *(const v4f*)(ssqg + (size_t)row * 16), s1 = *(const v4f*)(ssqg + (size_t)row * 16 + 4), s2 = *(const v4f*)(ssqg + (size_t)row * 16 + 8), s3 = *(const v4f*)(ssqg + (size_t)row * 16 + 12);
            const float qa = ((s0[0] + s0[1]) + (s0[2] + s0[3])) + ((s1[0] + s1[1]) + (s1[2] + s1[3])), qb = (s2[0] + s2[1]) + (s2[2] + s2[3]), qc = (s3[0] + s3[1]) + (s3[2] + s3[3]);
            const float vb = qb * (1.0f / 256.0f) + EPS, vc = qc * (1.0f / 256.0f) + EPS;
            const float ra = rsqrtf(qa * (1.0f / 512.0f) + EPS), rb = rsqrtf(vb), rc = rsqrtf(vc);
            const int r = ai * 64 + m * 16 + fr;
            F[r] = ra * (vb * rb); F[128 + r] = rb * (vc * rc); F[256 + r] = rc;
            asm volatile("" ::: "memory");
        }
    }
    DI void kscale(pg8::f32x4 (&acc)[2][2][4][2], int seg, int wid, int fr) const {
        const LAS float* F = (const LAS float*)fsl + wid * 384 + ((seg == 1) ? 0 : 128);
#pragma unroll
        for (int ai = 0; ai < 2; ++ai)
#pragma unroll
            for (int m = 0; m < 4; ++m) {
                const float f = F[ai * 64 + m * 16 + fr];
#pragma unroll
                for (int bj = 0; bj < 2; ++bj)
#pragma unroll
                    for (int n = 0; n < 2; ++n) acc[ai][bj][m][n] = acc[ai][bj][m][n] * f;
            }
    }
    DI void operator()(const pg8::f32x4 (&acc)[2][2][4][2], const pg8::Unit& u, int wr, int wc, int fr, int fq) const {
        const LAS float* F = (const LAS float*)fsl + (wr * 4 + wc) * 384 + 256;
#pragma unroll
        for (int ai = 0; ai < 2; ++ai)
#pragma unroll
            for (int m = 0; m < 4; ++m) {
                const int row = u.pm * 256 + ai * 128 + wr * 64 + m * 16 + fr;
                float sc = 1.f; if (KSEG) sc = F[ai * 64 + m * 16 + fr];
                float q = 0.f;
#pragma unroll
                for (int bj = 0; bj < 2; ++bj) {
                    const pg8::f32x4 v0 = acc[ai][bj][m][0] * sc, v1 = acc[ai][bj][m][1] * sc;
                    q += (v0[0] * v0[0] + v0[1] * v0[1]) + (v0[2] * v0[2] + v0[3] * v0[3]) + (v1[0] * v1[0] + v1[1] * v1[1]) + (v1[2] * v1[2] + v1[3] * v1[3]);
                    v4u w; w.x = pk2(v0[0], v0[1]); w.y = pk2(v0[2], v0[3]); w.z = pk2(v1[0], v1[1]); w.w = pk2(v1[2], v1[3]);
                    *(v4u*)(Y + (size_t)row * 1024 + u.pn * 256 + bj * 128 + wc * 32 + 8 * fq) = w;
                }
                q += __shfl_xor(q, 16); q += __shfl_xor(q, 32);
                if (fq == 0) ssq[(size_t)row * 16 + u.pn * 4 + wc] = q;
            }
    }
};

struct EpiProj {
    static constexpr bool PERM = true, AFTER_DRAIN = false, KSEG = false;
    bf16* O; const float* rstdx;
    DI void operator()(const pg8::f32x4 (&acc)[2][2][4][2], const pg8::Unit& u, int wr, int wc, int fr, int fq) const {
#pragma unroll
        for (int ai = 0; ai < 2; ++ai)
#pragma unroll
            for (int m = 0; m < 4; ++m) {
                const int row = u.pm * 256 + ai * 128 + wr * 64 + m * 16 + fr; const float rs = rstdx[row];
#pragma unroll
                for (int bj = 0; bj < 2; ++bj) {
                    const pg8::f32x4 v0 = acc[ai][bj][m][0] * rs, v1 = acc[ai][bj][m][1] * rs;
                    v4u w; w.x = pk2(v0[0], v0[1]); w.y = pk2(v0[2], v0[3]); w.z = pk2(v1[0], v1[1]); w.w = pk2(v1[2], v1[3]);
                    *(v4u*)(O + (size_t)row * NPROJ + u.pn * 256 + bj * 128 + wc * 32 + 8 * fq) = w;
                }
            }
    }
};
template <class Sched> DI void row_scales(const Sched& S, const float* slots2, float* rstdx, int tid) {
#pragma unroll
    for (int k = 0; k < 6; ++k) {
        pg8::Unit u; const bool ok = S.next((tid >> 8) + 2 * k, u);
        if (ok) {
            const size_t row = (size_t)u.pm * 256 + (tid & 255);
            const v4f s0 = *(const v4f*)(slots2 + row * 16), s1 = *(const v4f*)(slots2 + row * 16 + 4), s2 = *(const v4f*)(slots2 + row * 16 + 8), s3 = *(const v4f*)(slots2 + row * 16 + 12);
            const float s = (((s0[0] + s0[1]) + (s0[2] + s0[3])) + ((s1[0] + s1[1]) + (s1[2] + s1[3]))) + (((s2[0] + s2[1]) + (s2[2] + s2[3])) + ((s3[0] + s3[1]) + (s3[2] + s3[3])));
            rstdx[row] = rsqrtf(s * (1.0f / 1024.0f) + EPS);
        }
    }
    asm volatile("s_waitcnt vmcnt(0)" ::: "memory");
    __syncthreads();
}

DI bf16* a_row(unsigned char* ws, int row) {
    const int gb = row >> 12, s = row & 4095;
    return (bf16*)(s < 2816 ? ws + WS_PROJ + ((size_t)gb << 24) + (size_t)s * (DFF * 2) : ws + WS_MIX + ((size_t)gb << 23) + (size_t)(s - 2816) * (DFF * 2));
}
struct EpiConv {
    static constexpr bool PERM = true, AFTER_DRAIN = false, KSEG = false;
    unsigned char* wsb; const float* cwp; float* gside; LAS unsigned char* halo; const float* rstdx;
    DI void operator()(pg8::f32x4 (&acc)[2][2][4][2], const pg8::Unit& u, int wr, int wc, int fr, int fq) const {
        LAS v4f* H = (LAS v4f*)halo;
#pragma unroll
        for (int ai = 0; ai < 2; ++ai)
#pragma unroll
            for (int m = 0; m < 4; ++m) {
                const float rs = rstdx[u.pm * 256 + ai * 128 + wr * 64 + m * 16 + fr];
#pragma unroll
                for (int bj = 0; bj < 2; ++bj)
#pragma unroll
                    for (int n = 0; n < 2; ++n) acc[ai][bj][m][n] = acc[ai][bj][m][n] * rs;
            }
        const int hl = (fr & 1) + 2 * fq;
        if (fr >= 14) {
#pragma unroll
            for (int ai = 0; ai < 2; ++ai)
#pragma unroll
                for (int bj = 0; bj < 2; ++bj)
#pragma unroll
                    for (int n = 0; n < 2; ++n) { const pg8::f32x4 v = acc[ai][bj][3][n]; H[(((ai * 2 + wr) * 4 + wc) * 4 + bj * 2 + n) * 8 + hl] = (v4f){v[0], v[1], v[2], v[3]}; }
        }
        if (wr == 1 && fr >= 14) {
#pragma unroll
            for (int bj = 0; bj < 2; ++bj)
#pragma unroll
                for (int n = 0; n < 2; ++n) { const pg8::f32x4 v = acc[1][bj][3][n]; *(v4f*)(gside + (size_t)(u.pm * 4 + 2 + (fr - 14)) * NUP + u.pn * 256 + bj * 128 + wc * 32 + 8 * fq + 4 * n) = (v4f){v[0], v[1], v[2], v[3]}; }
        }
        if (wr == 0 && fr < 2) {
#pragma unroll
            for (int bj = 0; bj < 2; ++bj)
#pragma unroll
                for (int n = 0; n < 2; ++n) { const pg8::f32x4 v = acc[0][bj][0][n]; *(v4f*)(gside + (size_t)(u.pm * 4 + fr) * NUP + u.pn * 256 + bj * 128 + wc * 32 + 8 * fq + 4 * n) = (v4f){v[0], v[1], v[2], v[3]}; }
        }
        asm volatile("s_waitcnt lgkmcnt(0)\n\ts_barrier" ::: "memory");
#pragma unroll
        for (int n = 0; n < 2; ++n) {
            v4f w0[2], w1[2], w2[2], cb[2];
#pragma unroll
            for (int bj = 0; bj < 2; ++bj) {
                const float* p = cwp + u.pn * 256 + bj * 128 + wc * 32 + 8 * fq + 4 * n;
                w0[bj] = *(const v4f*)p; w1[bj] = *(const v4f*)(p + NUP); w2[bj] = *(const v4f*)(p + 2 * NUP); cb[bj] = *(const v4f*)(p + 3 * NUP);
            }
#pragma unroll
            for (int ai = 0; ai < 2; ++ai) {
                v4f hal[2];
                {
                    const bool has = (wr == 1) || (ai == 1);
                    const int as = (wr == 1) ? ai : 0, ws_ = (wr == 1) ? 0 : 1;
#pragma unroll
                    for (int bj = 0; bj < 2; ++bj) { v4f hv = H[(((as * 2 + ws_) * 4 + wc) * 4 + bj * 2 + n) * 8 + hl]; hal[bj] = has ? hv : (v4f){0.f, 0.f, 0.f, 0.f}; }
                }
#pragma unroll
                for (int m = 0; m < 4; ++m) {
                    float cv[2][4];
#pragma unroll
                    for (int bj = 0; bj < 2; ++bj) {
                        const pg8::f32x4 cur = acc[ai][bj][m][n];
                        pg8::f32x4 prv;
                        if (m > 0) prv = acc[ai][bj][m > 0 ? m - 1 : 0][n]; else prv = (pg8::f32x4){hal[bj][0], hal[bj][1], hal[bj][2], hal[bj][3]};
#pragma unroll
                        for (int i = 0; i < 4; ++i) {
                            const float q1 = dppf<0x121>(prv[i]), q2 = dppf<0x122>(prv[i]);
                            const float p1 = __int_as_float(__builtin_amdgcn_update_dpp(__float_as_int(q1), __float_as_int(cur[i]), 0x111, 0xf, 0xf, false));
                            const float p2 = __int_as_float(__builtin_amdgcn_update_dpp(__float_as_int(q2), __float_as_int(cur[i]), 0x112, 0xf, 0xf, false));
                            cv[bj][i] = cb[bj][i] + w0[bj][i] * p2 + w1[bj][i] * p1 + w2[bj][i] * cur[i];
                        }
                    }
                    float o[4];
#pragma unroll
                    for (int i = 0; i < 4; ++i) o[i] = gelu_tanh(cv[0][i]) * cv[1][i];
                    const int row = u.pm * 256 + ai * 128 + wr * 64 + m * 16 + fr;
                    v2u w; w.x = pk2(o[0], o[1]); w.y = pk2(o[2], o[3]);
                    *(v2u*)(a_row(wsb, row) + u.pn * 128 + wc * 32 + 8 * fq + 4 * n) = w;
                }
            }
        }
    }
};

#define XB_TMO      128
#define XB_XCNT(j)  (256  + 64 * (j))
#define XB_XSUB(j)  (1280 + 64 * (j))
#define XB_XGEN(j)  (2304 + 64 * (j))
#define XB_TOP      3328
#define XB_TOPGEN   3392
#define XCD_BAR_WORDS 3456
#define XB_SPIN_CAP (1u << 18)

__device__ __forceinline__ unsigned xb_ld(unsigned* p)              { return __hip_atomic_load(p, __ATOMIC_RELAXED, __HIP_MEMORY_SCOPE_AGENT); }
__device__ __forceinline__ unsigned xb_add(unsigned* p, unsigned v) { return __hip_atomic_fetch_add(p, v, __ATOMIC_RELAXED, __HIP_MEMORY_SCOPE_AGENT); }
__device__ __forceinline__ unsigned xb_xcc_id() { return (unsigned)__builtin_amdgcn_s_getreg((3 << 11) | 20) & 0xFu; }
#define XB_SPIN(cond, bar) do { unsigned _sp = 0; while (cond) { __builtin_amdgcn_s_sleep(1); \
    if ((++_sp & 255u) == 0u) { if (xb_ld(&(bar)[XB_TMO])) break; if (_sp > XB_SPIN_CAP) { atomicAdd(&(bar)[XB_TMO], 1u); break; } } } } while (0)

struct XcdBarrier {
    unsigned* bar; unsigned x;
    volatile LAS unsigned* st;
};

__device__ __forceinline__ XcdBarrier xcd_barrier_post(unsigned* bar, volatile LAS unsigned* st, int xtid) {
    XcdBarrier b; b.bar = bar; b.x = xb_xcc_id(); b.st = st;
    if (xtid == 0) (void)xb_add(&bar[XB_XCNT(b.x)], 1u);
    return b;
}
__device__ __forceinline__ void xcd_barrier_complete(unsigned* bar, unsigned x, unsigned& nloc, unsigned& nx) {
    const unsigned G = gridDim.x * gridDim.y * gridDim.z;
    unsigned sum, cnt, mine, sp = 0u;
    for (;;) {
        sum = 0u; cnt = 0u; mine = 0u;
#pragma unroll
        for (unsigned j = 0; j < 16; ++j) { const unsigned c = xb_ld(&bar[XB_XCNT(j)]); sum += c; cnt += (c > 0u) ? 1u : 0u; mine = (j == x) ? c : mine; }
        if (sum == G) break;
        __builtin_amdgcn_s_sleep(1);
        if ((++sp & 255u) == 0u) { if (xb_ld(&bar[XB_TMO])) break; if (sp > XB_SPIN_CAP) { atomicAdd(&bar[XB_TMO], 1u); break; } }
    }
    nloc = mine > 0u ? mine : 1u; nx = cnt > 0u ? cnt : 1u;
}

__device__ __forceinline__ void xcd_barrier(const XcdBarrier& b, int xtid) {
    asm volatile("s_waitcnt vmcnt(0)" ::: "memory");
    __syncthreads();
    if (xtid == 0) {
        unsigned* bar = b.bar;
        __builtin_amdgcn_s_waitcnt(0);
        unsigned nloc = b.st[0], nx = b.st[1];
        if (nloc == 0u) { xcd_barrier_complete(bar, b.x, nloc, nx); b.st[0] = nloc; b.st[1] = nx; }
        const unsigned old = xb_add(&bar[XB_XSUB(b.x)], 1u);
        const unsigned gen = old / nloc;
        if (old + 1u == (gen + 1u) * nloc) {
            __builtin_amdgcn_fence(__ATOMIC_RELEASE, "agent");
            asm volatile("s_waitcnt vmcnt(0)" ::: "memory");
            const unsigned og = xb_add(&bar[XB_TOP], 1u);
            const unsigned tg = og / nx;
            if (og + 1u == (tg + 1u) * nx) xb_add(&bar[XB_TOPGEN], 1u);
            else XB_SPIN(xb_ld(&bar[XB_TOPGEN]) == tg, bar);
            __builtin_amdgcn_fence(__ATOMIC_ACQUIRE, "agent");
            xb_add(&bar[XB_XGEN(b.x)], 1u);
            asm volatile("s_waitcnt vmcnt(0)" ::: "memory");
        } else {
            XB_SPIN(xb_ld(&bar[XB_XGEN(b.x)]) == gen, bar);
            __builtin_amdgcn_fence(__ATOMIC_ACQUIRE, "agent");
            asm volatile("s_waitcnt vmcnt(0)" ::: "memory");
        }
    }
    __syncthreads();
}

template <int MAP> DI int srccol(int n) {
    if (MAP == 0) return n;
    if (MAP == 1) return n < 1536 ? n : (n < 1952 ? n + 4 : (n < 1956 ? n - 416 : -1));
    if (MAP == 2) { const int pn = n >> 8, bj = (n >> 7) & 1, jj = n & 127; return bj * DFF + pn * 128 + jj; }
    { const int v = n >> 8, h = (n >> 6) & 3, j = n & 63; return h * 128 + v * 64 + j; }
}
template <int MAP> DI void cvt_item(const float* W, int K, int Nsrc, bf16* WT, int Ndst, const float* kgain, float scale, LAS float* scr, int item, int lane) {
    const int nblk = Ndst / 32, kb = item / nblk, nb = item % nblk, k0 = 64 * kb, n0 = 32 * nb;
    const int c4 = lane & 7, n4 = n0 + 4 * c4, sc = srccol<MAP>(n4);
    float cs = scale; if (MAP == 1) { cs = (n4 < 512 || (n4 >= 768 && n4 < 1024)) ? scale : 1.f; }
    v4f wv[8];
#pragma unroll
    for (int jx = 0; jx < 8; ++jx) { const int kk = (lane >> 3) + 8 * jx; wv[jx] = (sc >= 0) ? *(const v4f*)(W + (size_t)(k0 + kk) * Nsrc + sc) : (v4f){0.f, 0.f, 0.f, 0.f}; }
#pragma unroll
    for (int jx = 0; jx < 8; ++jx) {
        const int kk = (lane >> 3) + 8 * jx;
        float g = cs; if (kgain) g *= kgain[k0 + kk];
        LAS float* d = scr + kk * 33 + 4 * c4;
        d[0] = wv[jx][0] * g; d[1] = wv[jx][1] * g; d[2] = wv[jx][2] * g; d[3] = wv[jx][3] * g;
    }
    asm volatile("s_waitcnt lgkmcnt(0)" ::: "memory");
    const int c = lane & 7;
#pragma unroll
    for (int j = 0; j < 4; ++j) {
        const int nn = (lane >> 3) + 8 * j; const LAS float* s = scr + (8 * c) * 33 + nn;
        v4u o; o.x = pk2(s[0 * 33], s[1 * 33]); o.y = pk2(s[2 * 33], s[3 * 33]); o.z = pk2(s[4 * 33], s[5 * 33]); o.w = pk2(s[6 * 33], s[7 * 33]);
        *(v4u*)(WT + (size_t)(n0 + nn) * K + k0 + 8 * c) = o;
    }
    asm volatile("s_waitcnt lgkmcnt(0)" ::: "memory");
}

DI void row_update(float* xrow, const float* xin, const bf16* yrow, float* ssqp, const float* gpost, const float* gpre, bf16* hrow, int lane) {
    v4f v[4];
    const v4f* src = (const v4f*)(xin ? xin : xrow) + lane;
#pragma unroll
    for (int j = 0; j < 4; ++j) v[j] = src[64 * j];
    if (yrow) {
        const v4f s0 = *(const v4f*)ssqp, s1 = *(const v4f*)(ssqp + 4), s2 = *(const v4f*)(ssqp + 8), s3 = *(const v4f*)(ssqp + 12);
        const float sy = (((s0[0] + s0[1]) + (s0[2] + s0[3])) + ((s1[0] + s1[1]) + (s1[2] + s1[3]))) + (((s2[0] + s2[1]) + (s2[2] + s2[3])) + ((s3[0] + s3[1]) + (s3[2] + s3[3])));
        const float rsy = rsqrtf(sy * (1.0f / 1024.0f) + EPS);
        const v2u* yp = (const v2u*)yrow + lane;
#pragma unroll
        for (int j = 0; j < 4; ++j) {
            const v2u y = yp[64 * j]; const v4f g = ((const v4f*)gpost)[lane + 64 * j];
            v[j][0] += bflo(y.x) * rsy * g[0]; v[j][1] += bfhi(y.x) * rsy * g[1]; v[j][2] += bflo(y.y) * rsy * g[2]; v[j][3] += bfhi(y.y) * rsy * g[3];
        }
    }
    {
        v4f* dst = (v4f*)xrow + lane;
#pragma unroll
        for (int j = 0; j < 4; ++j) dst[64 * j] = v[j];
    }
    if (gpre) {
        float s = 0.f;
#pragma unroll
        for (int j = 0; j < 4; ++j) s += (v[j][0] * v[j][0] + v[j][1] * v[j][1]) + (v[j][2] * v[j][2] + v[j][3] * v[j][3]);
        const float rs = rsqrtf(wave_sum(s) * (1.0f / 1024.0f) + EPS);
        v2u* hp = (v2u*)hrow + lane;
#pragma unroll
        for (int j = 0; j < 4; ++j) {
            const v4f g = ((const v4f*)gpre)[lane + 64 * j];
            v2u w; w.x = pk2(v[j][0] * rs * g[0], v[j][1] * rs * g[1]); w.y = pk2(v[j][2] * rs * g[2], v[j][3] * rs * g[3]);
            hp[64 * j] = w;
        }
    }
}

struct RowExchange {
    float* slots; unsigned* cnt; unsigned* tmo; bool local;
    DI void run(const float (&part)[2][4], const pg8::Unit& u, int wr, int wc, int fr, int fq, int wid, int lane, LAS float* S, volatile LAS unsigned* flag) const {
        if (fq == 0) {
#pragma unroll
            for (int ai = 0; ai < 2; ++ai)
#pragma unroll
                for (int m = 0; m < 4; ++m) {
                    const int row = u.pm * 256 + ai * 128 + wr * 64 + m * 16 + fr;
                    if (local) slots[(size_t)row * 16 + u.pn * 4 + wc] = part[ai][m];
                    else __hip_atomic_store((unsigned*)slots + (size_t)row * 16 + u.pn * 4 + wc, __float_as_uint(part[ai][m]), __ATOMIC_RELAXED, __HIP_MEMORY_SCOPE_AGENT);
                }
        }
        asm volatile("s_waitcnt vmcnt(0)" ::: "memory");
        if (lane == 0) __hip_atomic_fetch_add(cnt + 64 * u.pm, 1u, __ATOMIC_RELAXED, __HIP_MEMORY_SCOPE_AGENT);
        if (wid == 0) {
            unsigned sp = 0;
            for (;;) {
                if ((unsigned)__builtin_amdgcn_readfirstlane(__hip_atomic_load(cnt + 64 * u.pm, __ATOMIC_RELAXED, __HIP_MEMORY_SCOPE_AGENT)) >= 32u) break;
                __builtin_amdgcn_s_sleep(2);
                if (++sp > (1u << 20)) { if (lane == 0) __hip_atomic_store(tmo, 1u, __ATOMIC_RELAXED, __HIP_MEMORY_SCOPE_AGENT); break; }
            }
            __builtin_amdgcn_fence(__ATOMIC_ACQUIRE, "agent");
        }
        asm volatile("s_waitcnt vmcnt(0) lgkmcnt(0)" ::: "memory"); __builtin_amdgcn_s_barrier(); asm volatile("" ::: "memory");
        int ln = lane; asm volatile("" : "+v"(ln));
        if (ln < 32) {
            const int r = wid * 32 + ln;
            const unsigned* sl = (const unsigned*)slots + (size_t)(u.pm * 256 + r) * 16;
            float v[16];
            if (local) {
                const v4f q0 = ((const v4f*)sl)[0], q1 = ((const v4f*)sl)[1], q2 = ((const v4f*)sl)[2], q3 = ((const v4f*)sl)[3];
#pragma unroll
                for (int k = 0; k < 4; ++k) { v[k] = q0[k]; v[4 + k] = q1[k]; v[8 + k] = q2[k]; v[12 + k] = q3[k]; }
            } else {
#pragma unroll
                for (int k = 0; k < 16; ++k) v[k] = __uint_as_float(__hip_atomic_load(sl + k, __ATOMIC_RELAXED, __HIP_MEMORY_SCOPE_AGENT));
            }
            const float s = (((v[0] + v[1]) + (v[2] + v[3])) + ((v[4] + v[5]) + (v[6] + v[7]))) + (((v[8] + v[9]) + (v[10] + v[11])) + ((v[12] + v[13]) + (v[14] + v[15])));
            S[r] = rsqrtf(s * (1.0f / 1024.0f) + EPS);
        }
        asm volatile("s_waitcnt lgkmcnt(0)" ::: "memory"); __builtin_amdgcn_s_barrier(); asm volatile("" ::: "memory");
    }
};
template <bool KSEG_> struct EpiRes {
    static constexpr bool PERM = true, AFTER_DRAIN = false, KSEG = KSEG_;
    AP a; int l; LAS unsigned char* fsl; int pm0, pn0; bool local;
    DI int ordinal(const pg8::Unit& u) const { return (u.pm == pm0 && u.pn == pn0) ? 0 : 1; }
    DI void kscale(pg8::f32x4 (&acc)[2][2][4][2], int seg, const pg8::Unit& u, int wr, int fr) const {
        const LAS float* F = (const LAS float*)fsl + (ordinal(u) * 3 + ((seg == 1) ? 0 : 1)) * 256 + wr * 64 + fr;
#pragma unroll
        for (int ai = 0; ai < 2; ++ai)
#pragma unroll
            for (int m = 0; m < 4; ++m) {
                const float f = F[ai * 128 + m * 16];
#pragma unroll
                for (int bj = 0; bj < 2; ++bj)
#pragma unroll
                    for (int n = 0; n < 2; ++n) acc[ai][bj][m][n] = acc[ai][bj][m][n] * f;
            }
    }
    DI void operator()(pg8::f32x4 (&acc)[2][2][4][2], const pg8::Unit& u, int wr, int wc, int fr, int fq) const {
        const int wid = wr * 4 + wc, lane = fr + 16 * fq;
        AP ap = a; asm volatile("" : "+s"(ap));
        unsigned char* ws = ap->ws; bf16* XB = (bf16*)(ws + WS_HB);
        const float* gpost = ap->in[KSEG ? I_APOST : I_FPOST] + l * 1024;
        const bool last = (!KSEG) && (l + 1 == DEPTH);
        float* OUT = ap->out;
        unsigned* cb = (unsigned*)(ws + WS_CTL + CTL_CNT_OFF) + (size_t)(l * 4 + (KSEG ? 0 : 2)) * 128 * 64;
        const RowExchange ex1{(float*)(ws + WS_SSQY), cb, (unsigned*)(ws + WS_CTL) + XB_TMO, local};
        float* slots2 = (float*)(ws + WS_SLOT2);
        LAS unsigned char* xl = fsl + 12288;
        LAS float* S = (LAS float*)xl; volatile LAS unsigned* flag = (volatile LAS unsigned*)(xl + 1024);
        float part[2][4];
#pragma unroll
        for (int ai = 0; ai < 2; ++ai)
#pragma unroll
            for (int m = 0; m < 4; ++m) {
                if (KSEG) { const float sc = ((const LAS float*)fsl)[(ordinal(u) * 3 + 2) * 256 + ai * 128 + wr * 64 + m * 16 + fr];
#pragma unroll
                    for (int bj = 0; bj < 2; ++bj)
#pragma unroll
                        for (int n = 0; n < 2; ++n) acc[ai][bj][m][n] = acc[ai][bj][m][n] * sc; }
                float q = 0.f;
#pragma unroll
                for (int bj = 0; bj < 2; ++bj)
#pragma unroll
                    for (int n = 0; n < 2; ++n) { const pg8::f32x4 v = acc[ai][bj][m][n]; q += (v[0] * v[0] + v[1] * v[1]) + (v[2] * v[2] + v[3] * v[3]); }
                q += __shfl_xor(q, 16); q += __shfl_xor(q, 32);
                part[ai][m] = q;
            }
        ex1.run(part, u, wr, wc, fr, fq, wid, lane, S, flag);
        const int colb = u.pn * 256 + wc * 32 + 8 * fq;
#pragma unroll
        for (int ai = 0; ai < 2; ++ai)
#pragma unroll
            for (int m = 0; m < 4; ++m) {
                const int rl = ai * 128 + wr * 64 + m * 16 + fr; const float r1 = S[rl];
                const size_t ro = (size_t)(u.pm * 256 + rl) * 1024 + colb;
                float q = 0.f;
#pragma unroll
                for (int bj = 0; bj < 2; ++bj) {
                    const v4u xw = *(const v4u*)(XB + ro + bj * 128);
                    const v4f g0 = *(const v4f*)(gpost + colb + bj * 128), g1 = *(const v4f*)(gpost + colb + bj * 128 + 4);
                    const pg8::f32x4 a0 = acc[ai][bj][m][0], a1 = acc[ai][bj][m][1];
                    float v[8];
                    v[0] = bflo(xw.x) + a0[0] * r1 * g0[0]; v[1] = bfhi(xw.x) + a0[1] * r1 * g0[1]; v[2] = bflo(xw.y) + a0[2] * r1 * g0[2]; v[3] = bfhi(xw.y) + a0[3] * r1 * g0[3];
                    v[4] = bflo(xw.z) + a1[0] * r1 * g1[0]; v[5] = bfhi(xw.z) + a1[1] * r1 * g1[1]; v[6] = bflo(xw.w) + a1[2] * r1 * g1[2]; v[7] = bfhi(xw.w) + a1[3] * r1 * g1[3];
                    q += ((v[0] * v[0] + v[1] * v[1]) + (v[2] * v[2] + v[3] * v[3])) + ((v[4] * v[4] + v[5] * v[5]) + (v[6] * v[6] + v[7] * v[7]));
                    if (last) { *(v4f*)(OUT + ro + bj * 128) = (v4f){v[0], v[1], v[2], v[3]}; *(v4f*)(OUT + ro + bj * 128 + 4) = (v4f){v[4], v[5], v[6], v[7]}; }
                    else { v4u w; w.x = pk2(v[0], v[1]); w.y = pk2(v[2], v[3]); w.z = pk2(v[4], v[5]); w.w = pk2(v[6], v[7]); *(v4u*)(XB + ro + bj * 128) = w; }
                }
                q += __shfl_xor(q, 16); q += __shfl_xor(q, 32);
                if (fq == 0) slots2[(size_t)(u.pm * 256 + rl) * 16 + u.pn * 4 + wc] = q;
                if (m & 1) asm volatile("" ::: "memory");
            }
        asm volatile("s_waitcnt lgkmcnt(0)" ::: "memory"); __builtin_amdgcn_s_barrier(); asm volatile("" ::: "memory");
    }
};

DI void seam_factors(const float* ssqg, int pm, LAS float* F, int tid) {
    if (tid < 256) {
        const size_t row = (size_t)pm * 256 + tid;
        const v4f s0 = *(const v4f*)(ssqg + row * 16), s1 = *(const v4f*)(ssqg + row * 16 + 4), s2 = *(const v4f*)(ssqg + row * 16 + 8), s3 = *(const v4f*)(ssqg + row * 16 + 12);
        const float qa = ((s0[0] + s0[1]) + (s0[2] + s0[3])) + ((s1[0] + s1[1]) + (s1[2] + s1[3])), qb = (s2[0] + s2[1]) + (s2[2] + s2[3]), qc = (s3[0] + s3[1]) + (s3[2] + s3[3]);
        const float vb = qb * (1.0f / 256.0f) + EPS, vc = qc * (1.0f / 256.0f) + EPS;
        const float ra = rsqrtf(qa * (1.0f / 512.0f) + EPS), rb = rsqrtf(vb), rc = rsqrtf(vc);
        F[tid] = ra * (vb * rb); F[256 + tid] = rb * (vc * rc); F[512 + tid] = rc;
    }
}

#define MFMA32(a, b, c) __builtin_amdgcn_mfma_f32_32x32x16_bf16((a), (b), (c), 0, 0, 0)

DI void prep_unit(AP a, int l, int unit, LAS unsigned char* lds, int tid, int lane, int wave) {
    unsigned char* ws = a->ws;
    const bf16* proj = (const bf16*)(ws + WS_PROJ);
    const bf16* Wuq = (const bf16*)(ws + WS_W + (size_t)l * W_LAYER + WO_UQ);
    const bf16* Wukv = (const bf16*)(ws + WS_W + (size_t)l * W_LAYER + WO_UKV);
    bf16* qm = (bf16*)(ws + WS_QM); bf16* km = (bf16*)(ws + WS_KM);
    bf16* vts = (bf16*)(ws + WS_VTS); bf16* vtf = (bf16*)(ws + WS_VTF); bf16* vtm = (bf16*)(ws + WS_VTM);
    const float* rope = (const float*)(ws + WS_ROPE);
    const int t0 = unit * 128, b = t0 / SEQ, s0 = t0 % SEQ;
    const int rb = wave & 3, half = wave >> 2, r32 = lane & 31, hi = lane >> 5;
    const int row = t0 + 32 * rb + r32, pos = s0 + 32 * rb + r32;
    {
        constexpr int WSZ = 32 * 528;
        LAS unsigned char* wb = lds + 1024 + half * 2 * WSZ;
        const int ht = tid & 255;
        v8s bq[16], bk[8]; float ssq_ = 0.f, ssk_ = 0.f;
#pragma unroll
        for (int ks = 0; ks < 16; ++ks) {
            bq[ks] = *(const v8s*)(proj + (size_t)row * NPROJ + C_CQ + 16 * ks + 8 * hi);
#pragma unroll
            for (int jx = 0; jx < 8; ++jx) { const float f = bf2f((unsigned short)bq[ks][jx]); ssq_ += f * f; }
        }
#pragma unroll
        for (int ks = 0; ks < 8; ++ks) {
            bk[ks] = *(const v8s*)(proj + (size_t)row * NPROJ + C_CKV + 16 * ks + 8 * hi);
#pragma unroll
            for (int jx = 0; jx < 8; ++jx) { const float f = bf2f((unsigned short)bk[ks][jx]); ssk_ += f * f; }
        }
        ssq_ += __shfl_xor(ssq_, 32); ssk_ += __shfl_xor(ssk_, 32);
        const float rstdq = rsqrtf(ssq_ * (1.0f / 256.0f) + EPS), rstdk = rsqrtf(ssk_ * (1.0f / 128.0f) + EPS);
        v4u wreg[4];
#define PW_LOAD(st) do { if ((st) < 6) { const bf16* src_ = Wuq + (size_t)(32 * (half * 6 + (st))) * 256; \
            _Pragma("unroll") for (int jx = 0; jx < 4; ++jx) { const int p_ = ht + 256 * jx; wreg[jx] = *(const v4u*)(src_ + (size_t)(p_ >> 5) * 256 + 8 * (p_ & 31)); } } \
        else { const bf16* src_ = Wukv + (size_t)(32 * (half * 8 + (st) - 6)) * 128; \
            _Pragma("unroll") for (int jx = 0; jx < 2; ++jx) { const int p_ = ht + 256 * jx; wreg[jx] = *(const v4u*)(src_ + (size_t)(p_ >> 4) * 128 + 8 * (p_ & 15)); } } } while (0)
#define PW_STORE(st, bf_) do { LAS unsigned char* d_ = wb + (bf_) * WSZ; if ((st) < 6) { \
            _Pragma("unroll") for (int jx = 0; jx < 4; ++jx) { const int p_ = ht + 256 * jx; *(LAS v4u*)(d_ + (p_ >> 5) * 528 + 16 * (p_ & 31)) = wreg[jx]; } } \
        else { _Pragma("unroll") for (int jx = 0; jx < 2; ++jx) { const int p_ = ht + 256 * jx; *(LAS v4u*)(d_ + (p_ >> 4) * 528 + 16 * (p_ & 15)) = wreg[jx]; } } } while (0)
        __syncthreads();
        PW_LOAD(0); PW_STORE(0, 0);
        __syncthreads();
#pragma unroll 1
        for (int st = 0; st < 14; ++st) {
            if (st + 1 < 14) PW_LOAD(st + 1);
            const LAS unsigned char* wp = wb + (st & 1) * WSZ + r32 * 528 + 16 * hi;
            v16f acc = {};
            if (st < 6) {
                const int cb = half * 6 + st;
#pragma unroll
                for (int ks = 0; ks < 16; ++ks) { const v8s af = *(const LAS v8s*)(wp + 32 * ks); acc = MFMA32(af, bq[ks], acc); }
#pragma unroll
                for (int r = 0; r < 16; ++r) acc[r] *= rstdq;
                if (st % 3 == 2) {
                    const v4f c0 = *(const v4f*)(rope + (size_t)pos * 32 + 4 * hi), c1 = *(const v4f*)(rope + (size_t)pos * 32 + 8 + 4 * hi);
                    const v4f s0v = *(const v4f*)(rope + (size_t)pos * 32 + 16 + 4 * hi), s1v = *(const v4f*)(rope + (size_t)pos * 32 + 24 + 4 * hi);
#pragma unroll
                    for (int r = 0; r < 8; ++r) {
                        const float c = (r < 4) ? c0[r & 3] : c1[r & 3], s = (r < 4) ? s0v[r & 3] : s1v[r & 3];
                        const float x1 = acc[r], x2 = acc[r + 8];
                        acc[r] = x1 * c - x2 * s; acc[r + 8] = x1 * s + x2 * c;
                    }
                }
#pragma unroll
                for (int g = 0; g < 4; ++g) { v2u w; w.x = pk2(acc[4 * g], acc[4 * g + 1]); w.y = pk2(acc[4 * g + 2], acc[4 * g + 3]); *(v2u*)(qm + (size_t)row * 384 + 32 * cb + 8 * g + 4 * hi) = w; }
            } else {
                const int cbi = st - 6;
#pragma unroll
                for (int ks = 0; ks < 8; ++ks) { const v8s af = *(const LAS v8s*)(wp + 32 * ks); acc = MFMA32(af, bk[ks], acc); }
#pragma unroll
                for (int r = 0; r < 16; ++r) acc[r] *= rstdk;
                const int head = cbi >> 1, off = 32 * (cbi & 1);
                if (half == 0) {
#pragma unroll
                    for (int g = 0; g < 4; ++g) { v2u w; w.x = pk2(acc[4 * g], acc[4 * g + 1]); w.y = pk2(acc[4 * g + 2], acc[4 * g + 3]); *(v2u*)(km + (size_t)row * 384 + 96 * head + off + 8 * g + 4 * hi) = w; }
                } else {
#pragma unroll
                    for (int r = 0; r < 16; ++r) { const int d = off + crow(r, hi); vtm[((size_t)(b * 4 + head) * 64 + d) * SEQ + pos] = (bf16)(pk2(acc[r], 0.f) & 0xffffu); }
                }
            }
            if (st + 1 < 14) PW_STORE(st + 1, (st + 1) & 1);
            __syncthreads();
        }
#undef PW_LOAD
#undef PW_STORE
    }
    {
        const int rl = tid >> 2, q4 = tid & 3; const int rw = t0 + rl, ps = s0 + rl;
        const v2u x1 = *(const v2u*)(proj + (size_t)rw * NPROJ + C_KR + 4 * q4), x2 = *(const v2u*)(proj + (size_t)rw * NPROJ + C_KR + 16 + 4 * q4);
        const v4f c = *(const v4f*)(rope + (size_t)ps * 32 + 4 * q4), s = *(const v4f*)(rope + (size_t)ps * 32 + 16 + 4 * q4);
        const float a1[4] = {bflo(x1.x), bfhi(x1.x), bflo(x1.y), bfhi(x1.y)}, a2[4] = {bflo(x2.x), bfhi(x2.x), bflo(x2.y), bfhi(x2.y)};
        float o1[4], o2[4];
#pragma unroll
        for (int i = 0; i < 4; ++i) { o1[i] = a1[i] * c[i] - a2[i] * s[i]; o2[i] = a1[i] * s[i] + a2[i] * c[i]; }
        v2u w1, w2; w1.x = pk2(o1[0], o1[1]); w1.y = pk2(o1[2], o1[3]); w2.x = pk2(o2[0], o2[1]); w2.y = pk2(o2[2], o2[3]);
#pragma unroll
        for (int h = 0; h < 4; ++h) { *(v2u*)(km + (size_t)rw * 384 + 96 * h + 64 + 4 * q4) = w1; *(v2u*)(km + (size_t)rw * 384 + 96 * h + 80 + 4 * q4) = w2; }
    }
#pragma unroll 4
    for (int k = 0; k < 12; ++k) {
        const int it = tid + 512 * k, c = it % 384, rg = it / 384;
        const int src = c < 128 ? C_SWAV + c : C_FOXV + (c - 128);
        unsigned short e[8];
#pragma unroll
        for (int j = 0; j < 8; ++j) e[j] = proj[(size_t)(t0 + 8 * rg + j) * NPROJ + src];
        v4u w; w.x = e[0] | ((unsigned)e[1] << 16); w.y = e[2] | ((unsigned)e[3] << 16); w.z = e[4] | ((unsigned)e[5] << 16); w.w = e[6] | ((unsigned)e[7] << 16);
        bf16* dst = c < 128 ? vts + ((size_t)(b * 2 + (c >> 6)) * 64 + (c & 63)) * SEQ : vtf + ((size_t)(b * 4 + ((c - 128) >> 6)) * 64 + ((c - 128) & 63)) * SEQ;
        *(v4u*)(dst + s0 + 8 * rg) = w;
    }
    {
        const int tk = tid >> 2, h = tid & 3;
        const v4u* kp = (const v4u*)(proj + (size_t)(t0 + tk) * NPROJ + C_FOXK + 64 * h);
        float ss = 0.f;
#pragma unroll
        for (int i = 0; i < 8; ++i) { const v4u w = kp[i]; const unsigned e[4] = {w.x, w.y, w.z, w.w};
#pragma unroll
            for (int j = 0; j < 4; ++j) { const float lo = bflo(e[j]), hi2 = bfhi(e[j]); ss += lo * lo + hi2 * hi2; } }
        float nm = sqrtf(ss);
#pragma unroll
        for (int o = 4; o < 64; o <<= 1) nm = fmaxf(nm, __shfl_xor(nm, o));
        LAS float* red = (LAS float*)lds;
        __syncthreads();
        if (lane < 4) red[wave * 4 + lane] = nm;
        __syncthreads();
        if (tid < 4) { float mx = red[tid]; for (int w = 1; w < 8; ++w) mx = fmaxf(mx, red[w * 4 + tid]); ((float*)(ws + WS_KNMAX))[(size_t)unit * 4 + tid] = mx; }
    }
    if (wave == 7) {
        const float* fb = a->in[I_FB] + l * 4;
        float* floc = (float*)(ws + WS_FLOC); float* ftot = (float*)(ws + WS_FTOT);
        const int r0 = t0 + 2 * lane;
        const v2u z0 = *(const v2u*)(proj + (size_t)r0 * NPROJ + C_FL), z1 = *(const v2u*)(proj + (size_t)(r0 + 1) * NPROJ + C_FL);
        const float za[4] = {bflo(z0.x), bfhi(z0.x), bflo(z0.y), bfhi(z0.y)}, zb[4] = {bflo(z1.x), bfhi(z1.x), bflo(z1.y), bfhi(z1.y)};
        v4f o0, o1, tt;
#pragma unroll
        for (int h = 0; h < 4; ++h) {
            const float xa = za[h] + fb[h], xb = zb[h] + fb[h];
            const float la = fminf(xa, 0.f) - __logf(1.0f + __expf(-fabsf(xa))), lb = fminf(xb, 0.f) - __logf(1.0f + __expf(-fabsf(xb)));
            const float tot = la + lb; float sc = tot;
#pragma unroll
            for (int o = 1; o < 64; o <<= 1) { const float v = __shfl_up(sc, o); if (lane >= o) sc += v; }
            const float ex = sc - tot;
            o0[h] = ex + la; o1[h] = ex + tot; tt[h] = sc;
        }
        *(v4f*)(floc + (size_t)r0 * 4) = o0; *(v4f*)(floc + (size_t)(r0 + 1) * 4) = o1;
        if (lane == 63) *(v4f*)(ftot + (size_t)unit * 4) = tt;
    }
}

template <int MODE> DI void attn_unit(int b, int qb, const bf16* Qb, int qpitch, const bf16* Kb, int kpitch, const bf16* VT, bf16* O, float* ssq,
                                      const float* aux, const float* aux2, const float* aux3, int auxstride, LAS unsigned char* lds, int tid, int lane, int wave) {
    constexpr int DK = (MODE == 2) ? 96 : 64, ND = DK / 16, PK = DK * 2 + 16, PCS = DK / 8;
    constexpr int KOFF = 0, KSZ = 64 * PK, VOFF = 2 * KSZ, VSZ = 64 * 136, FOFF = VOFF + 2 * VSZ, MSOFF = FOFF + 512;
    const int r32 = lane & 31, hi = lane >> 5;
    const size_t rowbase = (size_t)b * SEQ;
    const int q0 = qb * 256, qw0 = q0 + 32 * wave, q = qw0 + r32;
    LAS float* MS = (LAS float*)(lds + MSOFF);
    __syncthreads();
    if (MODE == 1) {
        if (wave == 0) {
            float v = (lane < 32) ? aux2[(size_t)lane * 4] : 0.f; const float own = v;
#pragma unroll
            for (int o = 1; o < 32; o <<= 1) { const float t = __shfl_up(v, o); if (lane >= o) v += t; }
            if (lane < 32) MS[lane] = v - own;
        }
        if (wave == 1) {
            float v = (lane < 32) ? aux3[(size_t)lane * 4] : 0.f;
#pragma unroll
            for (int o = 1; o < 32; o <<= 1) { const float t = __shfl_up(v, o); if (lane >= o) v = fmaxf(v, t); }
            if (lane < 32) MS[32 + lane] = v;
        }
    }
    if (MODE == 0) { if (tid < 320) { const int dist = 223 - tid; MS[tid] = ((unsigned)dist < 128u) ? aux[dist & 127] : NEGBIG; } }
    __syncthreads();
    v8s qr[ND];
#pragma unroll
    for (int d0 = 0; d0 < ND; ++d0) qr[d0] = *(const v8s*)(Qb + (rowbase + q) * qpitch + 16 * d0 + 8 * hi);
    const int kt_lo = (MODE == 0) ? (4 * qb - 2 > 0 ? 4 * qb - 2 : 0) : 0, kt_hi = 4 * qb + 3;
    v4u kreg0, kreg1 = {}, vreg; float freg = 0.f;
    const int krow0 = tid / PCS, kc0 = tid % PCS, krow1 = (tid + 512) / PCS, kc1 = (tid + 512) % PCS;
    const int vd = tid >> 3, vc = tid & 7;
#define ATT_LOAD(kt) do { \
        kreg0 = *(const v4u*)(Kb + (rowbase + 64 * (kt) + krow0) * kpitch + 8 * kc0); \
        if (DK == 96 && tid < 256) kreg1 = *(const v4u*)(Kb + (rowbase + 64 * (kt) + krow1) * kpitch + 8 * kc1); \
        vreg = *(const v4u*)(VT + (size_t)vd * SEQ + 64 * (kt) + 8 * vc); \
        if (MODE == 1 && tid < 64) freg = -(aux[(rowbase + 64 * (kt) + tid) * auxstride] + MS[(64 * (kt) + tid) >> 7]) * LOG2E; } while (0)
#define ATT_STORE(buf) do { \
        *(LAS v4u*)(lds + KOFF + (buf) * KSZ + krow0 * PK + 16 * kc0) = kreg0; \
        if (DK == 96 && tid < 256) *(LAS v4u*)(lds + KOFF + (buf) * KSZ + krow1 * PK + 16 * kc1) = kreg1; \
        { LAS unsigned char* vq_ = lds + VOFF + (buf) * VSZ + vd * 136 + 16 * vc; *(LAS v2u*)vq_ = (v2u){vreg.x, vreg.y}; *(LAS v2u*)(vq_ + 8) = (v2u){vreg.z, vreg.w}; } \
        if (MODE == 1 && tid < 64) ((LAS float*)(lds + FOFF + (buf) * 256))[tid] = freg; } while (0)
    constexpr bool REV = (MODE == 1);
    const int ntile = kt_hi - kt_lo + 1;
    float qn = 0.f;
    if (REV) {
#pragma unroll
        for (int d0 = 0; d0 < ND; ++d0)
#pragma unroll
            for (int j = 0; j < 8; ++j) { const float f = bf2f((unsigned short)qr[d0][j]); qn += f * f; }
        qn += __shfl_xor(qn, 32); qn = sqrtf(qn) * 1.01f;
    }
    ATT_LOAD(REV ? kt_hi : kt_lo); ATT_STORE(0);
    __syncthreads();
    float m = (MODE == 0) ? aux2[0] * LOG2E : NEGBIG;
    float lsum = (MODE == 0 && hi == 0) ? 1.f : 0.f;
    v16f o0 = {}, o1 = {};
    int buf = 0;
    bool seen = false;
    for (int it = 0; it < ntile; ++it) {
        const int kt = REV ? kt_hi - it : kt_lo + it;
        const bool more = it + 1 < ntile;
        if (more) ATT_LOAD(REV ? kt - 1 : kt + 1);
        const int k0 = 64 * kt;
        const bool active = (k0 <= qw0 + 31) && (MODE != 0 || k0 + 63 >= qw0 - 127);
        if (active) {
            const LAS unsigned char* kb = lds + KOFF + buf * KSZ + r32 * PK + 16 * hi;
            v16f p0, p1;
#pragma unroll
            for (int d0 = 0; d0 < ND; ++d0) {
                const v8s ka = *(const LAS v8s*)(kb + 32 * d0), kb2 = *(const LAS v8s*)(kb + 32 * PK + 32 * d0);
                if (d0 == 0) { p0 = MFMA32(ka, qr[0], (v16f){}); p1 = MFMA32(kb2, qr[0], (v16f){}); }
                else { p0 = MFMA32(ka, qr[d0], p0); p1 = MFMA32(kb2, qr[d0], p1); }
            }
            asm volatile("s_nop 15\n\ts_nop 7" : "+v"(p0), "+v"(p1));
            if (MODE == 1) {
                const LAS float* fb = (const LAS float*)(lds + FOFF + buf * 256);
#pragma unroll
                for (int g = 0; g < 4; ++g) {
                    const v4f f0 = *(const LAS v4f*)(fb + 8 * g + 4 * hi), f1 = *(const LAS v4f*)(fb + 32 + 8 * g + 4 * hi);
#pragma unroll
                    for (int i = 0; i < 4; ++i) { p0[4 * g + i] += f0[i]; p1[4 * g + i] += f1[i]; }
                }
            }
            if (MODE == 0) {
                const LAS float* tb = MS + (223 - q + k0 + 4 * hi);
#pragma unroll
                for (int r = 0; r < 16; ++r) { p0[r] += tb[(r & 3) + 8 * (r >> 2)]; p1[r] += tb[32 + (r & 3) + 8 * (r >> 2)]; }
            } else if (k0 + 63 > qw0) {
#pragma unroll
                for (int r = 0; r < 16; ++r) {
                    const int kv = k0 + crow(r, hi);
                    if (kv > q) p0[r] = NEGBIG;
                    if (kv + 32 > q) p1[r] = NEGBIG;
                }
            }
            float rm;
            { float ma = max3f(p0[0], p0[1], p1[0]), mb = max3f(p0[2], p0[3], p1[1]); ma = max3f(ma, p1[2], p1[3]);
#pragma unroll
              for (int r = 4; r < 16; r += 4) { ma = max3f(ma, p0[r], p0[r + 1]); mb = max3f(mb, p0[r + 2], p0[r + 3]); ma = max3f(ma, p1[r], p1[r + 1]); mb = max3f(mb, p1[r + 2], p1[r + 3]); }
              rm = max2f(ma, mb); }
            { const auto rr = __builtin_amdgcn_permlane32_swap(__float_as_uint(rm), __float_as_uint(rm), false, false); rm = max2f(__uint_as_float(rr[0]), __uint_as_float(rr[1])); }
            const float mn = max2f(m, rm), corr = __builtin_amdgcn_exp2f(m - mn);
            m = mn;
            float rs = 0.f;
#pragma unroll
            for (int r = 0; r < 16; ++r) { p0[r] = __builtin_amdgcn_exp2f(p0[r] - mn); p1[r] = __builtin_amdgcn_exp2f(p1[r] - mn); rs += p0[r] + p1[r]; }
            lsum = lsum * corr + rs;
            if (__any(corr != 1.0f)) {
#pragma unroll
                for (int r = 0; r < 16; ++r) { o0[r] *= corr; o1[r] *= corr; }
            }
            seen = true;
            const LAS unsigned char* vb = lds + VOFF + buf * VSZ + r32 * 136 + 8 * hi;
#pragma unroll
            for (int s4 = 0; s4 < 4; ++s4) {
                v4u pw;
                if (s4 == 0) { pw.x = pk2(p0[0], p0[1]); pw.y = pk2(p0[2], p0[3]); pw.z = pk2(p0[4], p0[5]); pw.w = pk2(p0[6], p0[7]); }
                if (s4 == 1) { pw.x = pk2(p0[8], p0[9]); pw.y = pk2(p0[10], p0[11]); pw.z = pk2(p0[12], p0[13]); pw.w = pk2(p0[14], p0[15]); }
                if (s4 == 2) { pw.x = pk2(p1[0], p1[1]); pw.y = pk2(p1[2], p1[3]); pw.z = pk2(p1[4], p1[5]); pw.w = pk2(p1[6], p1[7]); }
                if (s4 == 3) { pw.x = pk2(p1[8], p1[9]); pw.y = pk2(p1[10], p1[11]); pw.z = pk2(p1[12], p1[13]); pw.w = pk2(p1[14], p1[15]); }
                const v8s pf = __builtin_bit_cast(v8s, pw);
                const v2u a0 = *(const LAS v2u*)(vb + 32 * s4), a1 = *(const LAS v2u*)(vb + 32 * s4 + 16);
                const v2u c0 = *(const LAS v2u*)(vb + 32 * 136 + 32 * s4), c1 = *(const LAS v2u*)(vb + 32 * 136 + 32 * s4 + 16);
                const v4u va = {a0.x, a0.y, a1.x, a1.y}, vc2 = {c0.x, c0.y, c1.x, c1.y};
                o0 = MFMA32(__builtin_bit_cast(v8s, va), pf, o0);
                o1 = MFMA32(__builtin_bit_cast(v8s, vc2), pf, o1);
            }
        }
        if (more) ATT_STORE(buf ^ 1);
        if (REV) {
            int vote = 0;
            if (seen && kt > 0) { const float fb0 = ((const LAS float*)(lds + FOFF + buf * 256))[0]; const float kb = MS[32 + ((kt - 1) >> 1)]; vote = __all((qn * kb + fb0 - m) < -40.0f) ? 1 : 0; }
            volatile LAS int* vt = (volatile LAS int*)(MS + 64) + (it & 1) * 8;
            if (lane == 0) vt[wave] = vote;
            __syncthreads();
            const int stop = vt[0] & vt[1] & vt[2] & vt[3] & vt[4] & vt[5] & vt[6] & vt[7];
            if (stop) break;
        } else {
            __syncthreads();
        }
        buf ^= 1;
    }
#undef ATT_LOAD
#undef ATT_STORE
    lsum += __shfl_xor(lsum, 32);
    const float inv = 1.0f / lsum;
    float sq = 0.f;
#pragma unroll
    for (int r = 0; r < 16; ++r) { o0[r] *= inv; o1[r] *= inv; sq += o0[r] * o0[r] + o1[r] * o1[r]; }
    sq += __shfl_xor(sq, 32);
    if (hi == 0) ssq[(rowbase + q) * 16] = sq;
    {
        LAS unsigned char* stg = lds + 65536 + wave * 4608;
#pragma unroll
        for (int g = 0; g < 4; ++g) {
            v2u w; w.x = pk2(o0[4 * g], o0[4 * g + 1]); w.y = pk2(o0[4 * g + 2], o0[4 * g + 3]); *(LAS v2u*)(stg + r32 * 136 + (8 * g + 4 * hi) * 2) = w;
            v2u x; x.x = pk2(o1[4 * g], o1[4 * g + 1]); x.y = pk2(o1[4 * g + 2], o1[4 * g + 3]); *(LAS v2u*)(stg + r32 * 136 + (32 + 8 * g + 4 * hi) * 2) = x;
        }
        asm volatile("s_waitcnt lgkmcnt(0)" ::: "memory");
        bf16* ow = O + (rowbase + qw0) * 1024;
#pragma unroll
        for (int i = 0; i < 4; ++i) {
            const int row = i * 8 + (lane >> 3), ch = lane & 7;
            const v2u lo = *(const LAS v2u*)(stg + row * 136 + ch * 16), hi2 = *(const LAS v2u*)(stg + row * 136 + ch * 16 + 8);
            *(v4u*)(ow + (size_t)row * 1024 + ch * 8) = (v4u){lo.x, lo.y, hi2.x, hi2.y};
        }
    }
}

DI void attn_slot(AP a, int l, int v, LAS unsigned char* lds, int tid, int lane, int wave) {
    unsigned char* ws = a->ws;
    const bf16* proj = (const bf16*)(ws + WS_PROJ);
    const bf16* qm = (const bf16*)(ws + WS_QM); const bf16* km = (const bf16*)(ws + WS_KM);
    const bf16* vts = (const bf16*)(ws + WS_VTS); const bf16* vtf = (const bf16*)(ws + WS_VTF); const bf16* vtm = (const bf16*)(ws + WS_VTM);
    bf16* mix = (bf16*)(ws + WS_MIX); float* ssqg = (float*)(ws + WS_SSQG);
    const float* floc = (const float*)(ws + WS_FLOC); const float* ftot = (const float*)(ws + WS_FTOT);
    const float* btab = (const float*)(ws + WS_BTAB);
    const int bh = v >> 3, s = v & 7, b = bh >> 2, h = bh & 3;
#pragma unroll 1
    for (int i = 0; i < 2; ++i) {
        const int qb = i == 0 ? 15 - s : s;
        attn_unit<2>(b, qb, qm + 96 * h, 384, km + 96 * h, 384, vtm + (size_t)(b * 4 + h) * 64 * SEQ, mix + 768 + 64 * h, ssqg + 12 + h, nullptr, nullptr, nullptr, 0, lds, tid, lane, wave);
    }
#pragma unroll 1
    for (int i = 0; i < 2; ++i) {
        const int qb = i == 0 ? 15 - s : s;
        attn_unit<1>(b, qb, proj + C_FOXQ + 64 * h, NPROJ, proj + C_FOXK + 64 * h, NPROJ, vtf + (size_t)(b * 4 + h) * 64 * SEQ, mix + 512 + 64 * h, ssqg + 8 + h,
                     floc + h, ftot + (size_t)(b * 32) * 4 + h, (const float*)(ws + WS_KNMAX) + (size_t)(b * 32) * 4 + h, 4, lds, tid, lane, wave);
    }
#pragma unroll 1
    for (int i = 0; i < 4; ++i) {
        const int u = 4 * v + i, qb = u & 15, hq = (u >> 4) & 7, bb = u >> 7, kvh = hq >> 2;
        attn_unit<0>(bb, qb, proj + C_SWAQ + 64 * hq, NPROJ, proj + C_SWAK + 64 * kvh, NPROJ, vts + (size_t)(bb * 2 + kvh) * 64 * SEQ, mix + 64 * hq, ssqg + hq,
                     btab + hq * 128, a->in[I_SINK] + l * 8 + hq, nullptr, 0, lds, tid, lane, wave);
    }
}

DI void fixup_phase(AP a, int l, int gtid, int gthreads) {
    unsigned char* ws = a->ws;
    const float* gside = (const float*)(ws + WS_GSIDE); const float* cwp = (const float*)(ws + WS_CWP) + (size_t)l * 4 * NUP;
    bf16* A = (bf16*)(ws + WS_A);
    for (int it = gtid; it < 120 * 2 * 22 * 32; it += gthreads) {
        const int jj4 = it & 31, rest = it >> 5, pn = rest % 22, r2 = rest / 22, r = r2 & 1, tile = r2 >> 1;
        const int pm = (tile / 15) * 16 + 1 + tile % 15;
        float cv[2][4];
#pragma unroll
        for (int bj = 0; bj < 2; ++bj) {
            const int nidx = 256 * pn + 128 * bj + 4 * jj4;
            const v4f g0 = *(const v4f*)(gside + (size_t)(pm * 4 + r) * NUP + nidx);
            const v4f g1 = *(const v4f*)(gside + (size_t)(r == 1 ? pm * 4 + 0 : (pm - 1) * 4 + 3) * NUP + nidx);
            const v4f g2 = *(const v4f*)(gside + (size_t)(r == 1 ? (pm - 1) * 4 + 3 : (pm - 1) * 4 + 2) * NUP + nidx);
            const v4f w0 = *(const v4f*)(cwp + nidx), w1 = *(const v4f*)(cwp + NUP + nidx), w2 = *(const v4f*)(cwp + 2 * NUP + nidx), cb = *(const v4f*)(cwp + 3 * NUP + nidx);
#pragma unroll
            for (int i = 0; i < 4; ++i) cv[bj][i] = cb[i] + w0[i] * g2[i] + w1[i] * g1[i] + w2[i] * g0[i];
        }
        v2u w; w.x = pk2(gelu_tanh(cv[0][0]) * cv[1][0], gelu_tanh(cv[0][1]) * cv[1][1]); w.y = pk2(gelu_tanh(cv[0][2]) * cv[1][2], gelu_tanh(cv[0][3]) * cv[1][3]);
        *(v2u*)(A + (size_t)(256 * pm + r) * DFF + 128 * pn + 4 * jj4) = w;
    }
}

DI void fixup_panel(AP a, int l, int pm, int tid) {
    unsigned char* ws = a->ws;
    const float* gside = (const float*)(ws + WS_GSIDE); const float* cwp = (const float*)(ws + WS_CWP) + (size_t)l * 4 * NUP;
    for (int it = tid; it < 2 * 22 * 32; it += 512) {
        const int jj4 = it & 31, rest = it >> 5, pn = rest % 22, r = rest / 22;
        float cv[2][4];
#pragma unroll
        for (int bj = 0; bj < 2; ++bj) {
            const int nidx = 256 * pn + 128 * bj + 4 * jj4;
            const v4f g0 = *(const v4f*)(gside + (size_t)(pm * 4 + r) * NUP + nidx);
            const v4f g1 = *(const v4f*)(gside + (size_t)(r == 1 ? pm * 4 + 0 : (pm - 1) * 4 + 3) * NUP + nidx);
            const v4f g2 = *(const v4f*)(gside + (size_t)(r == 1 ? (pm - 1) * 4 + 3 : (pm - 1) * 4 + 2) * NUP + nidx);
            const v4f w0 = *(const v4f*)(cwp + nidx), w1 = *(const v4f*)(cwp + NUP + nidx), w2 = *(const v4f*)(cwp + 2 * NUP + nidx), cb = *(const v4f*)(cwp + 3 * NUP + nidx);
#pragma unroll
            for (int i = 0; i < 4; ++i) cv[bj][i] = cb[i] + w0[i] * g2[i] + w1[i] * g1[i] + w2[i] * g0[i];
        }
        v2u w; w.x = pk2(gelu_tanh(cv[0][0]) * cv[1][0], gelu_tanh(cv[0][1]) * cv[1][1]); w.y = pk2(gelu_tanh(cv[0][2]) * cv[1][2], gelu_tanh(cv[0][3]) * cv[1][3]);
        *(v2u*)(a_row(ws, 256 * pm + r) + 128 * pn + 4 * jj4) = w;
    }
}

DI void cvt_layers(AP a, LAS unsigned char* lds, int lane, int wave, int gw, int NGW, int l0, int nl) {
    unsigned char* ws = a->ws;
    LAS float* scr = (LAS float*)(lds + wave * 16384);
    constexpr int I_IN = 16 * 64, I_UQ = 4 * 12, I_UKV = 2 * 16, I_OUT = 16 * 32, I_UP = 16 * 176, I_DOWN = 44 * 32, I_LAYER = I_IN + I_UQ + I_UKV + I_OUT + I_UP + I_DOWN;
    for (int it = gw; it < nl * I_LAYER; it += NGW) {
        const int l = l0 + it / I_LAYER; int r = it % I_LAYER;
        unsigned char* wl = ws + WS_W + (size_t)l * W_LAYER;
        if (r < I_IN) { cvt_item<1>(a->in[I_WIN] + (size_t)l * 1024 * IN_COLS, 1024, IN_COLS, (bf16*)(wl + WO_IN), NPROJ, a->in[I_APRE] + l * 1024, C64, scr, r, lane); continue; } r -= I_IN;
        if (r < I_UQ) { cvt_item<0>(a->in[I_WUQ] + (size_t)l * 256 * 384, 256, 384, (bf16*)(wl + WO_UQ), 384, a->in[I_QLN] + l * 256, C96, scr, r, lane); continue; } r -= I_UQ;
        if (r < I_UKV) { cvt_item<3>(a->in[I_WUKV] + (size_t)l * 128 * 512, 128, 512, (bf16*)(wl + WO_UKV), 512, a->in[I_KVLN] + l * 128, 1.f, scr, r, lane); continue; } r -= I_UKV;
        if (r < I_OUT) { cvt_item<0>(a->in[I_WOUT] + (size_t)l * 1024 * 1024, 1024, 1024, (bf16*)(wl + WO_OUT), 1024, a->in[I_GN] + l * 1024, 1.f, scr, r, lane); continue; } r -= I_OUT;
        if (r < I_UP) { cvt_item<2>(a->in[I_WUP] + (size_t)l * 1024 * NUP, 1024, NUP, (bf16*)(wl + WO_UP), NUP, a->in[I_FPRE] + l * 1024, 1.f, scr, r, lane); continue; } r -= I_UP;
        cvt_item<0>(a->in[I_WDOWN] + (size_t)l * DFF * 1024, DFF, 1024, (bf16*)(wl + WO_DOWN), 1024, nullptr, 1.f, scr, r, lane);
    }
}

DI void prologue(AP a, LAS unsigned char* lds, int tid, int lane, int wave, int vcu, int G) {
    unsigned char* ws = a->ws;
    LAS float* scr = (LAS float*)(lds + wave * 16384);
    const int gw = vcu * 8 + wave, NGW = G * 8;
    cvt_layers(a, lds, lane, wave, gw, NGW, 0, 1);
    const int gtid = gw * 64 + lane, gth = NGW * 64;
    { float* rope = (float*)(ws + WS_ROPE);
      for (int i = gtid; i < SEQ * 16; i += gth) {
          const int pos = i >> 4, k = i & 15;
          const float inv = exp2f(-(float)k * (2.0f / 32.0f) * 13.287712379549449f);
          const float ang = (float)pos * inv;
          const float n = rintf(ang * 0.15915494309189535f);
          float rr = fmaf(-n, 6.28318548202514648f, ang); rr = fmaf(-n, -1.7484555e-7f, rr);
          rope[pos * 32 + k] = cosf(rr); rope[pos * 32 + 16 + k] = sinf(rr);
      } }
    { float* bt = (float*)(ws + WS_BTAB);
      for (int i = gtid; i < 8 * 128; i += gth) {
          const int h = i >> 7, d = i & 127; int bk = d;
          if (d >= 16) { bk = 16 + (int)(__log2f((float)d * (1.0f / 16.0f)) * (16.0f / 3.0f)); bk = bk > 31 ? 31 : bk; }
          bt[i] = a->in[I_RELB][bk * 8 + h] * LOG2E;
      } }
    { float* cwp = (float*)(ws + WS_CWP);
      for (int i = gtid; i < DEPTH * 4 * NUP; i += gth) {
          const int n = i % NUP, q = (i / NUP) & 3, l = i / (4 * NUP), sc = srccol<2>(n);
          cwp[i] = q < 3 ? a->in[I_CW][((size_t)l * 3 + q) * NUP + sc] : a->in[I_CB][(size_t)l * NUP + sc];
      } }
#pragma unroll 4
    for (int mrow = gw; mrow < T; mrow += NGW) {
        const v4f* src = (const v4f*)(a->in[I_X] + (size_t)mrow * 1024) + lane; v2u* hp = (v2u*)((bf16*)(ws + WS_HB) + (size_t)mrow * 1024) + lane;
        float s = 0.f;
#pragma unroll
        for (int j = 0; j < 4; ++j) { const v4f v = src[64 * j]; s += (v[0] * v[0] + v[1] * v[1]) + (v[2] * v[2] + v[3] * v[3]); v2u w; w.x = pk2(v[0], v[1]); w.y = pk2(v[2], v[3]); hp[64 * j] = w; }
        s = wave_sum(s);
        if (lane < 16) ((float*)(ws + WS_SLOT2))[(size_t)mrow * 16 + lane] = (lane == 0) ? s : 0.f;
    }
}

constexpr int NSP = 6, NPHASE = 1 + NSP * DEPTH;
#ifndef MK_PHM
#define MK_PHM 1023u
#endif
constexpr unsigned PHM = MK_PHM;
#ifndef MK_DUP
#define MK_DUP 0u
#endif
constexpr unsigned DUPM = MK_DUP;
__global__ void __launch_bounds__(512, 2) trunk_fwd(Args a_) {
    extern __shared__ __attribute__((aligned(16))) unsigned char lds_raw[];
    LAS unsigned char* lds = (LAS unsigned char*)lds_raw;
    cg::grid_group grid = cg::this_grid();
    const int tid0 = threadIdx.x, wave0 = __builtin_amdgcn_readfirstlane(tid0 >> 6);
    XcdBarrier bar; bar.bar = nullptr; bar.x = 0; bar.st = nullptr;
    if (a_.coop) {
        volatile LAS unsigned* misc = (volatile LAS unsigned*)(lds + MISC_OFF);
        if (tid0 < 16) misc[tid0] = 0u;
        __syncthreads();
        bar = xcd_barrier_post((unsigned*)(a_.ws + WS_CTL), misc + 8, tid0);
        if (tid0 == 0) {
            unsigned* fl = (unsigned*)(a_.ws + WS_CTL + CTL_FLAG_OFF); const unsigned g = blockIdx.x & 7u, xc = xb_xcc_id();
            atomicMax(fl + g, xc + 1u); atomicMax(fl + 8 + g, 16u - xc);
            if (gridDim.x != 256u) atomicOr(fl + 16, 1u);
        }
    }
    const int ph_lo = a_.ph_lo, ph_hi = a_.ph_hi, coop = a_.coop;
    bool fastseam = false; unsigned gepoch = 0u;
    for (int ph = ph_lo; ph < ph_hi; ++ph) {
        const int spx = ph == 0 ? 9 : (ph - 1) % NSP;
        for (int rep = 0; rep < (((DUPM >> spx) & 1u) ? 2 : 1); ++rep) {
        if (rep > 0 && coop) xcd_barrier(bar, wave0 * 64 + hw_lane());
        AP a = (AP)__builtin_amdgcn_kernarg_segment_ptr(); asm volatile("" : "+s"(a));
#define PH_TID() const int tid = wave0 * 64 + hw_lane(), lane = tid & 63, wave = wave0
        int G = gridDim.x, bx = blockIdx.x; asm volatile("" : "+s"(G), "+s"(bx));
        const int vcu = (G % 8 == 0) ? (bx % 8) * (G / 8) + bx / 8 : bx;
        unsigned char* ws = a->ws;
        if (ph == 0) {
            if (PHM & 512u) { PH_TID(); prologue(a, lds, tid, lane, wave, vcu, G); }
        } else {
            const int l = (ph - 1) / NSP, sp = (ph - 1) % NSP;
            unsigned char* wl = ws + WS_W + (size_t)l * W_LAYER;
            if (sp == 0 && (PHM & 1u)) {
                pg8::Gemm g{(const bf16*)(ws + WS_HB), (const bf16*)(wl + WO_IN), T, NPROJ, 1024}; pg8::StaticOrder S; S.init(T, NPROJ, G, bx);
                { PH_TID(); (void)lane; (void)wave; row_scales(S, (const float*)(ws + WS_SLOT2), (float*)(ws + WS_RSTDX), tid); }
                EpiProj E{(bf16*)(ws + WS_PROJ), (const float*)(ws + WS_RSTDX)};
                pg8::gemm_phase<EpiProj, pg8::StaticOrder, true, true>(lds, g, S, E, wave0 * 64 + hw_lane());
            } else if (sp == 1 && (PHM & 2u)) {
                PH_TID();
                if (l == 0) { cvt_layers(a, lds, lane, wave, vcu * 8 + wave, G * 8, 1, DEPTH - 1); __syncthreads(); }
                for (int u = vcu; u < T / 128; u += G) prep_unit(a, l, u, lds, tid, lane, wave);
            } else if (sp == 2 && (PHM & 4u)) {
                PH_TID(); for (int v = vcu; v < 256; v += G) attn_slot(a, l, v, lds, tid, lane, wave);
            } else if (sp == 3 && (PHM & 8u)) {
                pg8::Gemm g{(const bf16*)(ws + WS_MIX), (const bf16*)(wl + WO_OUT), T, 1024, 1024}; pg8::StaticOrder S; S.init(T, 1024, G, bx);
                pg8::Unit u0{-1, -1}, u1{-1, -1};
                { PH_TID(); (void)lane; (void)wave; const float* sg = (const float*)(ws + WS_SSQG);
                  if (S.next(0, u0)) seam_factors(sg, u0.pm, (LAS float*)(lds + HALO_OFF), tid);
                  if (S.next(1, u1)) seam_factors(sg, u1.pm, (LAS float*)(lds + HALO_OFF) + 768, tid);
                  __syncthreads(); }
                EpiRes<true> E{a, l, lds + HALO_OFF, u0.pm, u0.pn, fastseam};
                pg8::gemm_phase<EpiRes<true>, pg8::StaticOrder, true, true>(lds, g, S, E, wave0 * 64 + hw_lane());
            } else if (sp == 4 && (PHM & 32u)) {
                pg8::Gemm g{(const bf16*)(ws + WS_HB), (const bf16*)(wl + WO_UP), T, NUP, 1024}; pg8::StaticOrder S; S.init(T, NUP, G, bx);
                { PH_TID(); (void)lane; (void)wave; row_scales(S, (const float*)(ws + WS_SLOT2), (float*)(ws + WS_RSTDX), tid); }
                EpiConv E{ws, (const float*)(ws + WS_CWP) + (size_t)l * 4 * NUP, (float*)(ws + WS_GSIDE), lds + HALO_OFF, (const float*)(ws + WS_RSTDX)};
                pg8::gemm_phase<EpiConv, pg8::StaticOrder, true, true>(lds, g, S, E, wave0 * 64 + hw_lane());
            } else if (sp == 5 && (PHM & 128u)) {
                pg8::Gemm g{(const bf16*)(ws + WS_PROJ), (const bf16*)(wl + WO_DOWN), T, 1024, DFF, (const char*)(ws + WS_MIX)}; pg8::StaticOrder S; S.init(T, 1024, G, bx);
                { PH_TID(); (void)lane; (void)wave; pg8::Unit u;
                  for (int i = 0; S.next(i, u); ++i) if ((u.pm & 15) != 0) fixup_panel(a, l, u.pm, tid);
                  asm volatile("s_waitcnt vmcnt(0)" ::: "memory"); __syncthreads(); }
                EpiRes<false> E{a, l, lds + HALO_OFF, 0, 0, fastseam};
                pg8::gemm_phase<EpiRes<false>, pg8::StaticOrder, true, true>(lds, g, S, E, wave0 * 64 + hw_lane());
            }
        }
        }
        if (ph + 1 < ph_hi && coop && ph == 0) { grid.sync(); { const unsigned* fl = (const unsigned*)(a_.ws + WS_CTL + CTL_FLAG_OFF); bool ok = __hip_atomic_load(fl + 16, __ATOMIC_RELAXED, __HIP_MEMORY_SCOPE_AGENT) == 0u;
            for (int g = 0; g < 8; ++g) { const unsigned mx = __hip_atomic_load(fl + g, __ATOMIC_RELAXED, __HIP_MEMORY_SCOPE_AGENT), mi = __hip_atomic_load(fl + 8 + g, __ATOMIC_RELAXED, __HIP_MEMORY_SCOPE_AGENT); ok = ok && (mx + mi == 17u); }
            fastseam = ok; } }
        else if (ph + 1 < ph_hi && coop && fastseam && ph != 2) {        xcd_local_barrier((unsigned*)(a_.ws + WS_CTL + CTL_GRP_OFF) + 64 * (blockIdx.x & 7u), gepoch, wave0 * 64 + hw_lane()); ++gepoch; }
        else if (ph + 1 < ph_hi) { if (coop) { if (ph == 0) grid.sync(); else xcd_barrier(bar, wave0 * 64 + hw_lane()); if (DUPM & 1024u) xcd_barrier(bar, wave0 * 64 + hw_lane()); } }
    }
}

#ifndef MK_COOP
#define MK_COOP 0
#endif
extern "C" void kernel_launch(void* const* d_in, const int* in_sizes, int n_in, void* d_out, int out_size, void* d_ws, size_t ws_size, hipStream_t stream) {
    static int grid = 0;
    if (grid == 0) {
        if (n_in != 19 || out_size != T * 1024 || ws_size < WS_END) { fprintf(stderr, "kernel_launch: unexpected shapes (n_in %d out %d ws %zu)\n", n_in, out_size, ws_size); grid = -1; return; }
        int dev = 0, cus = 0, per_cu = 0;
        hipGetDevice(&dev); hipDeviceGetAttribute(&cus, hipDeviceAttributeMultiprocessorCount, dev);
        hipFuncSetAttribute((const void*)trunk_fwd, hipFuncAttributeMaxDynamicSharedMemorySize, LDS_BYTES);
        hipOccupancyMaxActiveBlocksPerMultiprocessor(&per_cu, (const void*)trunk_fwd, 512, LDS_BYTES);
        if (per_cu < 1) { fprintf(stderr, "kernel_launch: occupancy query says %d blocks/CU\n", per_cu); per_cu = 1; }
        (void)hipGetLastError();
        grid = cus * per_cu;
        fprintf(stderr, "kernel_launch: grid %d (cus %d x %d)\n", grid, cus, per_cu);
    }
    if (grid < 0) return;
    Args a{};
    for (int i = 0; i < 19; ++i) a.in[i] = (const float*)d_in[i];
    a.out = (float*)d_out; a.ws = (unsigned char*)d_ws; a.pad = 0;
#if MK_COOP
    if (hipMemsetAsync((char*)d_ws + WS_CTL, 0, CTL_BYTES, stream) != hipSuccess) { fprintf(stderr, "kernel_launch: memset of barrier words failed\n"); return; }
    a.ph_lo = 0; a.ph_hi = NPHASE; a.coop = 1;
    void* args[] = {&a};
    hipError_t e = hipLaunchCooperativeKernel((const void*)trunk_fwd, dim3(grid), dim3(512), args, LDS_BYTES, stream);
    if (e != hipSuccess) fprintf(stderr, "cooperative launch failed: %s (grid %d)\n", hipGetErrorString(e), grid);
#else
    a.coop = 0;
    for (int ph = 0; ph < NPHASE; ++ph) {
        a.ph_lo = ph; a.ph_hi = ph + 1;
        hipLaunchKernelGGL(trunk_fwd, dim3(grid), dim3(512), LDS_BYTES, stream, a);
    }
#endif
}
```
